# Optimizing an MI355X kernel written in HIP

```python
import jax, jax.numpy as jnp
from jax import lax
import numpy as np

D_MODEL = 2048
BATCH = 8
SEQ = 2048
DEPTH = 2

HEAD_DIM = 128
A_WIDTH = D_MODEL // 2
A_HEADS = A_WIDTH // HEAD_DIM
MOBA_BLOCK = 256
MOBA_TOPK = 3
Q_CHUNK = 128
ROPE_THETA = 500000.0
ROPE_DIM = HEAD_DIM // 4
ATTN_SCALE = HEAD_DIM ** -0.5
G_VAL_WIDTH = D_MODEL - A_WIDTH
G_HEADS = 4
G_VAL_DIM = G_VAL_WIDTH // G_HEADS
G_KEY_WIDTH = G_VAL_WIDTH // 2
G_KEY_DIM = G_KEY_WIDTH // G_HEADS
GATE_RANK = 16
GATE_TAU = 16.0
GLA_CHUNK = 64
MIX_WIDTH = A_WIDTH + G_VAL_WIDTH
IN_SIZES = [A_WIDTH, A_WIDTH, A_WIDTH, G_KEY_WIDTH, G_KEY_WIDTH, G_VAL_WIDTH, G_VAL_WIDTH, GATE_RANK]
IN_WIDTH = sum(IN_SIZES)
IN_SPLITS = np.cumsum(IN_SIZES)[:-1].tolist()
N_GROUPS = 4
EXPERTS_PER_GROUP = 8
N_EXPERTS = N_GROUPS * EXPERTS_PER_GROUP
TOP_K = 2
D_EXPERT = D_MODEL // 2
MOE_BLOCK = 128
EPS = 1e-6

kernel_name = 'hymba_moba_gla_hmoe_adaln'


def rms_norm(x, g):
    xf = x.astype(jnp.float32)
    y = xf * lax.rsqrt(jnp.mean(xf * xf, axis=-1, keepdims=True) + EPS)
    return (y * g.astype(jnp.float32)).astype(x.dtype)


def partial_rotary(x):
    S = x.shape[1]
    half = ROPE_DIM // 2
    inv = jnp.power(ROPE_THETA, -jnp.arange(half, dtype=jnp.float32) * (2.0 / ROPE_DIM))
    ang = jnp.arange(S, dtype=jnp.float32)[:, None] * inv[None, :]
    cos = jnp.cos(ang)[None, :, None, :]
    sin = jnp.sin(ang)[None, :, None, :]
    xr = x[..., :ROPE_DIM].astype(jnp.float32)
    x1, x2 = xr[..., :half], xr[..., half:]
    rot = jnp.concatenate([x1 * cos - x2 * sin, x2 * cos + x1 * sin], axis=-1).astype(x.dtype)
    return jnp.concatenate([rot, x[..., ROPE_DIM:]], axis=-1)


def moba_sequence(q, k, v):
    H, S, Dh = q.shape
    n_blk = max(-(-S // MOBA_BLOCK), MOBA_TOPK)
    pad = n_blk * MOBA_BLOCK - S
    k_p = jnp.pad(k, ((0, 0), (0, pad), (0, 0)))
    v_p = jnp.pad(v, ((0, 0), (0, pad), (0, 0)))
    kb = k_p.reshape(H, n_blk, MOBA_BLOCK, Dh)
    vb = v_p.reshape(H, n_blk, MOBA_BLOCK, Dh)
    kmean = jnp.mean(kb.astype(jnp.float32), axis=2).astype(k.dtype)
    n_chunks = S // Q_CHUNK

    def chunk(ci):
        q0 = ci * Q_CHUNK
        qc = lax.dynamic_slice_in_dim(q, q0, Q_CHUNK, axis=1)
        qpos = q0 + jnp.arange(Q_CHUNK)
        blk = q0 // MOBA_BLOCK
        gate = jnp.einsum('hqd,hnd->hqn', qc, kmean).astype(jnp.float32)
        past = jnp.arange(n_blk) < blk
        gate = jnp.where(past[None, None, :], gate, -jnp.inf)
        _, sel = lax.top_k(gate, MOBA_TOPK)
        valid = jnp.arange(MOBA_TOPK) < blk
        ksel = jax.vmap(lambda kh, ih: kh[ih])(kb, sel)
        vsel = jax.vmap(lambda vh, ih: vh[ih])(vb, sel)
        s_sel = jnp.einsum('hqd,hqkld->hqkl', qc, ksel).astype(jnp.float32)
        s_sel = jnp.where(valid[None, None, :, None], s_sel, -jnp.inf)
        s_sel = s_sel.reshape(H, Q_CHUNK, MOBA_TOPK * MOBA_BLOCK)
        kown = lax.dynamic_slice_in_dim(k_p, blk * MOBA_BLOCK, MOBA_BLOCK, axis=1)
        vown = lax.dynamic_slice_in_dim(v_p, blk * MOBA_BLOCK, MOBA_BLOCK, axis=1)
        kpos = blk * MOBA_BLOCK + jnp.arange(MOBA_BLOCK)
        s_own = jnp.einsum('hqd,hld->hql', qc, kown).astype(jnp.float32)
        s_own = jnp.where(kpos[None, None, :] <= qpos[None, :, None], s_own, -jnp.inf)
        p = jax.nn.softmax(jnp.concatenate([s_sel, s_own], axis=-1), axis=-1).astype(v.dtype)
        p_sel = p[..., :MOBA_TOPK * MOBA_BLOCK].reshape(H, Q_CHUNK, MOBA_TOPK, MOBA_BLOCK)
        p_own = p[..., MOBA_TOPK * MOBA_BLOCK:]
        return (jnp.einsum('hqkl,hqkld->hqd', p_sel, vsel)
                + jnp.einsum('hql,hld->hqd', p_own, vown))

    out = lax.map(chunk, jnp.arange(n_chunks))
    return out.transpose(1, 0, 2, 3).reshape(H, S, Dh)


def moba_attention(q, k, v):
    return lax.map(lambda a: moba_sequence(a[0], a[1], a[2]), (q, k, v))


def gla_chunked(q, k, v, log_a):
    B, S, H, dk = q.shape
    dv = v.shape[-1]
    nc = S // GLA_CHUNK

    def blocks(t):
        return t.reshape(B, nc, GLA_CHUNK, H, t.shape[-1]).transpose(0, 3, 1, 2, 4)

    q, k, v, la = blocks(q), blocks(k), blocks(v), blocks(log_a)
    b = jnp.cumsum(la, axis=3)
    b_last = b[:, :, :, -1:, :]
    q_dec = q * jnp.exp(b)
    k_inv = k * jnp.exp(-b)
    k_end = k * jnp.exp(b_last - b)
    causal = jnp.tril(jnp.ones((GLA_CHUNK, GLA_CHUNK), dtype=bool))
    att = jnp.einsum('bhnte,bhnse->bhnts', q_dec, k_inv)
    att = jnp.where(causal, att, 0.0)
    o_intra = jnp.einsum('bhnts,bhnsv->bhntv', att, v)
    kv = jnp.einsum('bhnse,bhnsv->bhnev', k_end, v)
    decay = jnp.exp(b_last[:, :, :, 0, :])

    def step(state, inp):
        d, kvc = inp
        return d[..., None] * state + kvc, state

    init = jnp.zeros((B, H, dk, dv), jnp.float32)
    _, s_prev = lax.scan(step, init, (decay.transpose(2, 0, 1, 3), kv.transpose(2, 0, 1, 3, 4)))
    s_prev = s_prev.transpose(1, 2, 0, 3, 4)
    o_inter = jnp.einsum('bhnte,bhnev->bhntv', q_dec, s_prev)
    return (o_intra + o_inter).transpose(0, 2, 3, 1, 4).reshape(B, S, H, dv)


def gla_mixer(q, k, v, og, ga, w_gk, b_gk, g_onorm):
    B, S, _ = q.shape
    f32 = jnp.float32
    q = q.reshape(B, S, G_HEADS, G_KEY_DIM).astype(f32) * (G_KEY_DIM ** -0.5)
    k = k.reshape(B, S, G_HEADS, G_KEY_DIM).astype(f32)
    v = v.reshape(B, S, G_HEADS, G_VAL_DIM).astype(f32)
    z = (ga @ w_gk + b_gk).astype(f32).reshape(B, S, G_HEADS, G_KEY_DIM)
    log_a = jax.nn.log_sigmoid(z) / GATE_TAU
    o = gla_chunked(q, k, v, log_a)
    o = o * lax.rsqrt(jnp.mean(o * o, axis=-1, keepdims=True) + EPS) * g_onorm.astype(f32)
    o = o * jax.nn.silu(og.reshape(B, S, G_HEADS, G_VAL_DIM).astype(f32))
    return o.reshape(B, S, G_VAL_WIDTH).astype(og.dtype)


def hier_moe(h, w_r1, b_r1, w_r2, b_r2, w_gate, w_up, w_down):
    B, S, D = h.shape
    T = B * S
    t = h.reshape(T, D)
    tf = t.astype(jnp.float32)
    l1 = tf @ w_r1.astype(jnp.float32) + b_r1.astype(jnp.float32)
    p1 = jax.nn.softmax(l1, axis=-1)
    grp = jnp.argmax(l1, axis=-1)
    p_grp = jnp.take_along_axis(p1, grp[:, None], axis=-1)
    l2 = (tf @ w_r2.astype(jnp.float32) + b_r2.astype(jnp.float32)).reshape(T, N_GROUPS, EXPERTS_PER_GROUP)
    l2g = jnp.take_along_axis(l2, grp[:, None, None], axis=1)[:, 0]
    v2, i2 = lax.top_k(l2g, TOP_K)
    p2 = jax.nn.softmax(v2, axis=-1)
    weights = (p_grp * p2).reshape(-1)
    experts = (grp[:, None] * EXPERTS_PER_GROUP + i2).reshape(-1).astype(jnp.int32)
    tokens = jnp.repeat(jnp.arange(T, dtype=jnp.int32), TOP_K)
    N = T * TOP_K
    counts = jnp.zeros((N_EXPERTS,), jnp.int32).at[experts].add(1)
    padded = (counts + MOE_BLOCK - 1) // MOE_BLOCK * MOE_BLOCK
    ends = jnp.cumsum(padded)
    starts = ends - padded
    cstart = jnp.cumsum(counts) - counts
    order = jnp.argsort(experts)
    e_sorted = experts[order]
    rank = jnp.arange(N, dtype=jnp.int32) - cstart[e_sorted]
    dest = starts[e_sorted] + rank
    P = -(-N // MOE_BLOCK) * MOE_BLOCK + N_EXPERTS * MOE_BLOCK
    n_blocks = P // MOE_BLOCK
    slot_tok = jnp.full((P,), T, jnp.int32).at[dest].set(tokens[order])
    slot_w = jnp.zeros((P,), h.dtype).at[dest].set(weights[order].astype(h.dtype))
    block_exp = jnp.minimum(jnp.searchsorted(ends, jnp.arange(n_blocks) * MOE_BLOCK, side='right'),
                            N_EXPERTS - 1).astype(jnp.int32)
    t_pad = jnp.concatenate([t, jnp.zeros((1, D), t.dtype)], axis=0)
    xb = t_pad[slot_tok].reshape(n_blocks, MOE_BLOCK, D)

    def run(args):
        xblk, e = args
        return (jax.nn.silu(xblk @ w_gate[e]) * (xblk @ w_up[e])) @ w_down[e]

    yb = lax.map(run, (xb, block_exp)).reshape(P, D)
    y = jax.ops.segment_sum(yb * slot_w[:, None], slot_tok, num_segments=T + 1)[:T]
    return y.reshape(B, S, D)


def setup_inputs(seed: int = 0) -> dict:
    key = jax.random.key(seed)
    ks = jax.random.split(key, 20)
    f32 = jnp.float32

    def nrm(k, shape, scale):
        return jax.random.normal(k, shape, f32) * scale

    return {
        'x': nrm(ks[0], (BATCH, SEQ, D_MODEL), 1.0),
        'c': nrm(ks[1], (BATCH, D_MODEL), 1.0),
        'ln1': 1.0 + nrm(ks[2], (DEPTH, D_MODEL), 0.02),
        'ln2': 1.0 + nrm(ks[3], (DEPTH, D_MODEL), 0.02),
        'w_ada': nrm(ks[4], (DEPTH, D_MODEL, 6 * D_MODEL), 0.5 * D_MODEL ** -0.5),
        'b_ada': nrm(ks[5], (DEPTH, 6 * D_MODEL), 0.02),
        'w_in': nrm(ks[6], (DEPTH, D_MODEL, IN_WIDTH), D_MODEL ** -0.5),
        'w_gk': nrm(ks[7], (DEPTH, GATE_RANK, G_KEY_WIDTH), GATE_RANK ** -0.5),
        'b_gk': nrm(ks[8], (DEPTH, G_KEY_WIDTH), 0.1),
        'g_onorm': 1.0 + nrm(ks[9], (DEPTH, G_VAL_DIM), 0.02),
        'w_out': nrm(ks[10], (DEPTH, MIX_WIDTH, D_MODEL), MIX_WIDTH ** -0.5),
        'w_r1': nrm(ks[11], (DEPTH, D_MODEL, N_GROUPS), D_MODEL ** -0.5),
        'b_r1': nrm(ks[12], (DEPTH, N_GROUPS), 0.01),
        'w_r2': nrm(ks[13], (DEPTH, D_MODEL, N_EXPERTS), D_MODEL ** -0.5),
        'b_r2': nrm(ks[14], (DEPTH, N_EXPERTS), 0.01),
        'w_e_gate': nrm(ks[15], (DEPTH, N_EXPERTS, D_MODEL, D_EXPERT), D_MODEL ** -0.5),
        'w_e_up': nrm(ks[16], (DEPTH, N_EXPERTS, D_MODEL, D_EXPERT), D_MODEL ** -0.5),
        'w_e_down': nrm(ks[17], (DEPTH, N_EXPERTS, D_EXPERT, D_MODEL), D_EXPERT ** -0.5),
        'ln_f': 1.0 + nrm(ks[18], (D_MODEL,), 0.02),
    }


def reference(x, c, ln1, ln2, w_ada, b_ada, w_in, w_gk, b_gk, g_onorm, w_out,
              w_r1, b_r1, w_r2, b_r2, w_e_gate, w_e_up, w_e_down, ln_f):
    B, S, D = x.shape
    c_act = jax.nn.silu(c)
    for l in range(DEPTH):
        mod = (c_act @ w_ada[l] + b_ada[l])[:, None, :]
        sh1, sc1, gt1, sh2, sc2, gt2 = jnp.split(mod, 6, axis=-1)
        h = rms_norm(x, ln1[l]) * (1.0 + sc1) + sh1
        proj = h @ w_in[l]
        qa, ka, va, qg, kg, vg, og, ga = jnp.split(proj, IN_SPLITS, axis=-1)
        qa = partial_rotary(qa.reshape(B, S, A_HEADS, HEAD_DIM)) * ATTN_SCALE
        ka = partial_rotary(ka.reshape(B, S, A_HEADS, HEAD_DIM))
        va = va.reshape(B, S, A_HEADS, HEAD_DIM)
        oa = moba_attention(qa.transpose(0, 2, 1, 3), ka.transpose(0, 2, 1, 3), va.transpose(0, 2, 1, 3))
        oa = oa.transpose(0, 2, 1, 3).reshape(B, S, A_WIDTH)
        ob = gla_mixer(qg, kg, vg, og, ga, w_gk[l], b_gk[l], g_onorm[l])
        mix = jnp.concatenate([oa, ob], axis=-1) @ w_out[l]
        x = x + gt1 * mix
        h2 = rms_norm(x, ln2[l]) * (1.0 + sc2) + sh2
        x = x + gt2 * hier_moe(h2, w_r1[l], b_r1[l], w_r2[l], b_r2[l], w_e_gate[l], w_e_up[l], w_e_down[l])
    return rms_norm(x, ln_f)
```

```cpp
#include <hip/hip_runtime.h>
#include <stdint.h>

#define DM 2048
#define NBATCH 8
#define SEQ 2048
#define NTOK (NBATCH * SEQ)
#define INW 6160
#define OFF_GA 6144
#define NEXP 32
#define DEXP 1024
#define ECAP 16384
#define EPSV 1e-6f


#define LAS __attribute__((address_space(3)))
typedef unsigned short bf16_t;
typedef short bf16x8 __attribute__((ext_vector_type(8)));
typedef float f32x4 __attribute__((ext_vector_type(4)));
typedef unsigned u32x4 __attribute__((ext_vector_type(4)));
typedef unsigned u32x2 __attribute__((ext_vector_type(2)));

#define ATTN_SCALE_F 0.08838834764831845f
#define QSCALE (ATTN_SCALE_F * 1.4426950408889634f)

typedef float f32x2_t __attribute__((ext_vector_type(2)));
typedef __bf16 bf16x2_t __attribute__((ext_vector_type(2)));
__device__ __forceinline__ unsigned cvt_pk_bf16(float lo, float hi) { const bf16x2_t r = __builtin_convertvector((f32x2_t){lo, hi}, bf16x2_t); return __builtin_bit_cast(unsigned, r); }
__device__ __forceinline__ float silu_fast(float x) { return x * __builtin_amdgcn_rcpf(1.0f + __builtin_amdgcn_exp2f(-x * 1.4426950408889634f)); }
__device__ __forceinline__ float bf_lo(unsigned w) { return __uint_as_float(w << 16); }
__device__ __forceinline__ float bf_hi(unsigned w) { return __uint_as_float(w & 0xffff0000u); }

__device__ __forceinline__ int mk_tid(const int wv) { int ln; asm volatile("v_mbcnt_lo_u32_b32 %0, -1, 0\n\tv_mbcnt_hi_u32_b32 %0, -1, %0" : "=v"(ln)); return wv * 64 + ln; }

constexpr size_t AL(size_t x) { return (x + 255) & ~(size_t)255; }
constexpr size_t WS_CTL = 0;
constexpr size_t CTL_BYTES = 32768;
constexpr size_t WS_CNT = WS_CTL + 16384;
constexpr size_t WS_MOD = AL(WS_CTL + CTL_BYTES);
constexpr size_t WS_ROPE = AL(WS_MOD + (size_t)2 * 8 * 6 * DM * 4);
constexpr size_t WS_KMEAN = AL(WS_ROPE + (size_t)SEQ * 32 * 4);
constexpr size_t WS_WIN = AL(WS_KMEAN + (size_t)2 * 8 * 8 * 8 * 128 * 4);
constexpr size_t WS_WOUT = AL(WS_WIN + (size_t)2 * 6144 * DM * 2);
constexpr size_t WS_WGU = AL(WS_WOUT + (size_t)2 * DM * DM * 2);
constexpr size_t WS_WD = AL(WS_WGU + (size_t)2 * NEXP * 2048 * DM * 2);
constexpr size_t WS_X = AL(WS_WD + (size_t)2 * NEXP * DM * DEXP * 2);
constexpr size_t WS_H = AL(WS_X + (size_t)NTOK * DM * 4);
constexpr size_t WS_Q = AL(WS_H + (size_t)NTOK * DM * 2);
constexpr size_t WS_K = AL(WS_Q + (size_t)NTOK * 1024 * 2);
constexpr size_t WS_VT = AL(WS_K + (size_t)NTOK * 1024 * 2);
constexpr size_t WS_QG = AL(WS_VT + (size_t)NTOK * 1024 * 2);
constexpr size_t WS_KG = AL(WS_QG + (size_t)NTOK * 512 * 2);
constexpr size_t WS_VG = AL(WS_KG + (size_t)NTOK * 512 * 2);
constexpr size_t WS_OG = AL(WS_VG + (size_t)NTOK * 1024 * 2);
constexpr size_t WS_LA = AL(WS_OG + (size_t)NTOK * 1024 * 2);
constexpr size_t WS_MIX = AL(WS_LA + (size_t)NTOK * 512 * 4);
constexpr size_t WS_ACT = AL(WS_MIX + (size_t)NTOK * DM * 2);
constexpr size_t WS_YB = AL(WS_ACT + (size_t)2 * NTOK * DEXP * 2);
constexpr size_t WS_SLOT = AL(WS_YB + (size_t)2 * NTOK * DM * 2);
constexpr size_t WS_TOKW = AL(WS_SLOT + (size_t)NEXP * ECAP * 4);
constexpr size_t WS_WRF = AL(WS_TOKW + (size_t)NTOK * 2 * 4);
constexpr size_t WS_WGAF = AL(WS_WRF + (size_t)2 * 64 * 3 * 2 * 64 * 16);
constexpr size_t WS_KE = AL(WS_WGAF + (size_t)2 * 64 * 2 * 64 * 16);
constexpr size_t WS_FAST_END = AL(WS_KE + (size_t)NTOK * 512 * 2);

constexpr int LDS_BYTES = 163840;
constexpr int LDS_MISC = 163840 - 64;
constexpr int NPHASE = 16;

struct MkArgs {
    const float* in[19]; float* out; unsigned char* ws; int ph_lo, ph_hi;
};

#define XB_TMO      128
#define XB_XCNT(j)  (256  + 64 * (j))
#define XB_XSUB(j)  (1280 + 64 * (j))
#define XB_XGEN(j)  (2304 + 64 * (j))
#define XB_TOP      3328
#define XB_TOPGEN   3392
#define XCD_BAR_WORDS 3456
#define XB_SPIN_CAP (1u << 18)
__device__ __forceinline__ unsigned xb_ld(unsigned* p)              { return __hip_atomic_load(p, __ATOMIC_RELAXED, __HIP_MEMORY_SCOPE_AGENT); }
__device__ __forceinline__ unsigned xb_add(unsigned* p, unsigned v) { return __hip_atomic_fetch_add(p, v, __ATOMIC_RELAXED, __HIP_MEMORY_SCOPE_AGENT); }
__device__ __forceinline__ unsigned xb_xcc_id() { return (unsigned)__builtin_amdgcn_s_getreg((3 << 11) | 20) & 0xFu; }
#define XB_SPIN(cond, bar) do { unsigned _sp = 0; while (cond) { __builtin_amdgcn_s_sleep(1); \
    if ((++_sp & 255u) == 0u) { if (xb_ld(&(bar)[XB_TMO])) break; if (_sp > XB_SPIN_CAP) { atomicAdd(&(bar)[XB_TMO], 1u); break; } } } } while (0)
struct XcdBarrier { unsigned* bar; unsigned x; volatile LAS unsigned* st; int wv; };
__device__ __forceinline__ XcdBarrier xcd_barrier_post(unsigned* bar, volatile LAS unsigned* st, const int wv) {
    XcdBarrier b; b.bar = bar; b.x = xb_xcc_id(); b.st = st; b.wv = wv;
    if (mk_tid(wv) == 0) (void)xb_add(&bar[XB_XCNT(b.x)], 1u);
    return b;
}
__device__ __forceinline__ void xcd_barrier_complete(unsigned* bar, unsigned x, unsigned& nloc, unsigned& nx) {
    const unsigned G = gridDim.x * gridDim.y * gridDim.z;
    unsigned sum, cnt, mine, sp = 0u;
    for (;;) {
        sum = 0u; cnt = 0u; mine = 0u;
#pragma unroll
        for (unsigned j = 0; j < 16; ++j) { const unsigned c = xb_ld(&bar[XB_XCNT(j)]); sum += c; cnt += (c > 0u) ? 1u : 0u; mine = (j == x) ? c : mine; }
        if (sum == G) break;
        __builtin_amdgcn_s_sleep(1);
        if ((++sp & 255u) == 0u) { if (xb_ld(&bar[XB_TMO])) break; if (sp > XB_SPIN_CAP) { atomicAdd(&bar[XB_TMO], 1u); break; } }
    }
    nloc = mine > 0u ? mine : 1u; nx = cnt > 0u ? cnt : 1u;
}
__device__ __forceinline__ void xcd_barrier(const XcdBarrier& b) {
    asm volatile("s_waitcnt vmcnt(0)" ::: "memory");
    __syncthreads();
    if (mk_tid(b.wv) == 0) {
        unsigned* bar = b.bar;
        __builtin_amdgcn_s_waitcnt(0);
        unsigned nloc = b.st[0], nx = b.st[1];
        if (nloc == 0u) { xcd_barrier_complete(bar, b.x, nloc, nx); b.st[0] = nloc; b.st[1] = nx; }
        const unsigned old = xb_add(&bar[XB_XSUB(b.x)], 1u);
        const unsigned gen = old / nloc;
        if (old + 1u == (gen + 1u) * nloc) {
            __builtin_amdgcn_fence(__ATOMIC_RELEASE, "agent");
            asm volatile("s_waitcnt vmcnt(0)" ::: "memory");
            const unsigned og = xb_add(&bar[XB_TOP], 1u);
            const unsigned tg = og / nx;
            if (og + 1u == (tg + 1u) * nx) xb_add(&bar[XB_TOPGEN], 1u);
            else XB_SPIN(xb_ld(&bar[XB_TOPGEN]) == tg, bar);
            __builtin_amdgcn_fence(__ATOMIC_ACQUIRE, "agent");
            xb_add(&bar[XB_XGEN(b.x)], 1u);
            asm volatile("s_waitcnt vmcnt(0)" ::: "memory");
        } else {
            XB_SPIN(xb_ld(&bar[XB_XGEN(b.x)]) == gen, bar);
            __builtin_amdgcn_fence(__ATOMIC_ACQUIRE, "agent");
            asm volatile("s_waitcnt vmcnt(0)" ::: "memory");
        }
    }
    __syncthreads();
}

constexpr int NT_IN = 2 * 16 * 48, NT_OUT = 2 * 16 * 16, NT_G = 64 * 16 * 8, NT_D = 64 * 8 * 16;
constexpr int NT_ALL = NT_IN + NT_OUT + 2 * NT_G + NT_D;
__device__ __forceinline__ void cvt_decode(int t, const float* w_in, const float* w_out, const float* w_eg, const float* w_eu, const float* w_ed,
                                           bf16_t* WinT, bf16_t* WoutT, bf16_t* WguT, bf16_t* WdT, const float*& s_, bf16_t*& d_, int& ld_, int& K_) {
    if (t < 2 * NT_G) { const int which = t / NT_G, t3 = t % NT_G, le = t3 / 128, r = t3 % 128, kt = r / 8, nt = r % 8;
        s_ = (which ? w_eu : w_eg) + (size_t)le * DM * DEXP + (size_t)kt * 128 * DEXP + nt * 128; ld_ = DEXP; K_ = DM;
        d_ = WguT + (size_t)le * 2048 * DM + (size_t)(nt * 256 + which * 128) * DM + kt * 128; }
    else if (t < 2 * NT_G + NT_D) { const int t2 = t - 2 * NT_G, le = t2 / 128, r = t2 % 128, kt = r / 16, nt = r % 16;
        s_ = w_ed + (size_t)le * DEXP * DM + (size_t)kt * 128 * DM + nt * 128; ld_ = DM; K_ = DEXP; d_ = WdT + (size_t)le * DM * DEXP + (size_t)nt * 128 * DEXP + kt * 128; }
    else if (t < 2 * NT_G + NT_D + NT_OUT) { const int t2 = t - 2 * NT_G - NT_D, l = 1 - t2 / 256, r = t2 % 256, kt = r / 16, nt = r % 16;
        s_ = w_out + (size_t)l * DM * DM + (size_t)kt * 128 * DM + nt * 128; ld_ = DM; K_ = DM; d_ = WoutT + (size_t)l * DM * DM + (size_t)nt * 128 * DM + kt * 128; }
    else { const int t2 = t - 2 * NT_G - NT_D - NT_OUT, l = 1 - t2 / (16 * 48), r = t2 % (16 * 48), kt = r / 48, nt = r % 48;
        s_ = w_in + (size_t)l * DM * INW + (size_t)kt * 128 * INW + nt * 128; ld_ = INW; K_ = DM; d_ = WinT + (size_t)l * 6144 * DM + (size_t)nt * 128 * DM + kt * 128; }
}
constexpr int DEF_RES6 = 2048;
constexpr int DEF_RES7 = 768 + 256;
constexpr int NT_PRO = 3 * 4096 - DEF_RES6 + 256 + 768, NT_DEF = 3 * 4096, DEF_CAP3 = 5504;
__device__ __forceinline__ int cvt_map(int i, bool deferred) {
    if (deferred) {
        if (i >= NT_DEF) { const int j = i - NT_DEF; if (j < DEF_RES6) return 16384 + 4096 - DEF_RES6 + j;
            const int r = j - DEF_RES6; return r < 768 ? 24576 + 512 + r : 24576 + (r - 768); }
        return i < 4096 ? 4096 + i : (i < 8192 ? i + 8192 : i + 12288); }
    if (i < 12288 - DEF_RES6) return i < 4096 ? i : (i < 8192 ? i + 4096 : i + 8192);
    const int k = i - (12288 - DEF_RES6);
    return k < 256 ? 24576 + 256 + k : 24576 + 1280 + (k - 256);
}
__device__ __forceinline__ void cvt_range(const MkArgs& a, LAS unsigned char* lds, const int tid, const int first, const int step, const int end, const bool deferred) {
    unsigned char* ws = a.ws;
    constexpr int RS = 320;
    const float* w_in = a.in[6]; const float* w_out = a.in[10]; const float* w_eg = a.in[15]; const float* w_eu = a.in[16]; const float* w_ed = a.in[17];
    bf16_t* WinT = (bf16_t*)(ws + WS_WIN); bf16_t* WoutT = (bf16_t*)(ws + WS_WOUT); bf16_t* WguT = (bf16_t*)(ws + WS_WGU); bf16_t* WdT = (bf16_t*)(ws + WS_WD);
    const int kk = tid >> 5, c4 = tid & 31;
    f32x4 v[8], vn[8], vm[8];
    const float* src = nullptr; bf16_t* dst = nullptr; int ld = 0, K = 0;
    const float* srcn = nullptr; bf16_t* dstn = nullptr; int ldn = 0, Kn = 0;
    int t = first;
    if (t < end) { cvt_decode(cvt_map(t, deferred), w_in, w_out, w_eg, w_eu, w_ed, WinT, WoutT, WguT, WdT, src, dst, ld, K);
#pragma unroll
        for (int i = 0; i < 8; ++i) v[i] = __builtin_nontemporal_load((const f32x4*)(src + (size_t)(kk + 16 * i) * ld + c4 * 4)); }
    if (t + step < end) { cvt_decode(cvt_map(t + step, deferred), w_in, w_out, w_eg, w_eu, w_ed, WinT, WoutT, WguT, WdT, srcn, dstn, ldn, Kn);
#pragma unroll
        for (int i = 0; i < 8; ++i) vn[i] = __builtin_nontemporal_load((const f32x4*)(srcn + (size_t)(kk + 16 * i) * ldn + c4 * 4)); }
    while (t < end) {
        const int tm = t + 2 * step; const float* srcm = nullptr; bf16_t* dstm = nullptr; int ldm = 0, Km = 0;
        if (tm < end) { cvt_decode(cvt_map(tm, deferred), w_in, w_out, w_eg, w_eu, w_ed, WinT, WoutT, WguT, WdT, srcm, dstm, ldm, Km);
#pragma unroll
            for (int i = 0; i < 8; ++i) vm[i] = __builtin_nontemporal_load((const f32x4*)(srcm + (size_t)(kk + 16 * i) * ldm + c4 * 4)); }
#pragma unroll
        for (int i = 0; i < 8; ++i) {
            u32x2 p; p[0] = cvt_pk_bf16(v[i][0], v[i][1]); p[1] = cvt_pk_bf16(v[i][2], v[i][3]);
            *(LAS u32x2*)(lds + (kk + 16 * i) * RS + c4 * 8) = p;
        }
        __syncthreads();
        {
            typedef short s16x4_t __attribute__((ext_vector_type(4)));
            const int ln = tid & 63, wq = tid >> 6, li = ln & 15, gq = li >> 2, gp = li & 3, G4 = ln >> 4;
#pragma unroll
            for (int i = 0; i < 4; ++i) {
                const int nb = wq, k8 = 2 * (G4 + 4 * (i >> 1)) + (i & 1);
                const LAS unsigned char* p0 = lds + (8 * k8 + gq) * RS + (16 * nb + 4 * gp) * 2;
                const s16x4_t x0 = __builtin_amdgcn_ds_read_tr16_b64_v4i16((LAS s16x4_t*)p0), x1 = __builtin_amdgcn_ds_read_tr16_b64_v4i16((LAS s16x4_t*)(p0 + 4 * RS));
                typedef short s16x8_t __attribute__((ext_vector_type(8)));
                const s16x8_t o8 = (s16x8_t){x0[0], x0[1], x0[2], x0[3], x1[0], x1[1], x1[2], x1[3]};
                *(u32x4*)(dst + (size_t)(16 * nb + li) * K + k8 * 8) = __builtin_bit_cast(u32x4, o8);
            }
        }
        __syncthreads();
        t += step; src = srcn; dst = dstn; ld = ldn; K = Kn; srcn = srcm; dstn = dstm; ldn = ldm; Kn = Km;
#pragma unroll
        for (int i = 0; i < 8; ++i) { v[i] = vn[i]; vn[i] = vm[i]; }
    }
}
__device__ __forceinline__ void cvt_deferred(const MkArgs& a, LAS unsigned char* lds, const int wv, unsigned* queue, const int lo, const int hi) {
    int tid = mk_tid(wv); asm volatile("" : "+v"(tid));
    LAS int* slot = (LAS int*)(lds + 49152);
    for (;;) {
        __syncthreads();
        if (tid == 0) *slot = lo + (int)atomicAdd(queue, 4u);
        __syncthreads();
        const int base = *slot;
        if (base >= hi) break;
        cvt_range(a, lds, tid, base, 1, (base + 4 < hi) ? base + 4 : hi, true);
    }
}
__device__ __forceinline__ void p0_prologue(const MkArgs& a, LAS unsigned char* lds, const int wv) {
    int tid = mk_tid(wv); asm volatile("" : "+v"(tid));
    const int G = gridDim.x, bx = blockIdx.x;
    unsigned char* ws = a.ws;
    {
        float* rope = (float*)(ws + WS_ROPE);
        for (int idx = bx * 512 + tid; idx < SEQ * 16; idx += G * 512) {
            const int pos = idx >> 4, i = idx & 15;
            const float inv = powf(500000.0f, -(float)i * (2.0f / 32.0f));
            const float ang = (float)pos * inv;
            rope[pos * 32 + i] = cosf(ang); rope[pos * 32 + 16 + i] = sinf(ang);
        }
        float* km = (float*)(ws + WS_KMEAN);
        for (int idx = bx * 512 + tid; idx < 2 * 8 * 8 * 8 * 128; idx += G * 512) km[idx] = 0.f;
    }
    {
        u32x4* wrf = (u32x4*)(ws + WS_WRF); u32x4* wgaf = (u32x4*)(ws + WS_WGAF);
        for (int idx = bx * 512 + tid; idx < 2 * 64 * 4 * 64; idx += G * 512) {
            const int ln = idx & 63, nt = (idx >> 6) & 3, ks = (idx >> 8) & 63, l = idx >> 14;
            const int n = 16 * nt + (ln & 15), k0 = 32 * ks + 8 * (ln >> 4);
            float v[8];
#pragma unroll
            for (int j = 0; j < 8; ++j) {
                const int k = k0 + j;
                if (nt == 3) v[j] = a.in[6][((size_t)l * DM + k) * INW + OFF_GA + (ln & 15)];
                else v[j] = n < 4 ? a.in[11][((size_t)l * DM + k) * 4 + n] : (n < 36 ? a.in[13][((size_t)l * DM + k) * 32 + n - 4] : 0.f);
            }
            u32x4 hi, lo;
#pragma unroll
            for (int e = 0; e < 4; ++e) { const unsigned hp = cvt_pk_bf16(v[2 * e], v[2 * e + 1]); hi[e] = hp; lo[e] = cvt_pk_bf16(v[2 * e] - bf_lo(hp), v[2 * e + 1] - bf_hi(hp)); }
            if (nt == 3) { wgaf[(((size_t)l * 64 + ks) * 2 + 0) * 64 + ln] = hi; wgaf[(((size_t)l * 64 + ks) * 2 + 1) * 64 + ln] = lo; }
            else { wrf[((((size_t)l * 64 + ks) * 3 + nt) * 2 + 0) * 64 + ln] = hi; wrf[((((size_t)l * 64 + ks) * 3 + nt) * 2 + 1) * 64 + ln] = lo; }
        }
    }
    {
        LAS float* cact = (LAS float*)lds;
        LAS float* red = (LAS float*)(lds + 65536);
        const float* c = a.in[1]; const float* w_ada = a.in[4]; const float* b_ada = a.in[5];
        float* mod = (float*)(ws + WS_MOD);
        for (int i = tid; i < NBATCH * DM; i += 512) { const float v = c[i]; cact[i] = v / (1.0f + expf(-v)); }
        __syncthreads();
        for (int cb = bx; cb < 256; cb += G) {
            const int l = cb >> 7, j0 = (cb & 127) * 96;
            if (tid < 384) {
                const int cg = tid % 24, ks = tid / 24;
                f32x4 acc[8];
#pragma unroll
                for (int b = 0; b < 8; ++b) acc[b] = (f32x4){0.f, 0.f, 0.f, 0.f};
                const float* wp = w_ada + ((size_t)l * DM + ks * 128) * (6 * DM) + j0 + cg * 4;
#pragma unroll 8
                for (int k = 0; k < 128; ++k) {
                    const f32x4 w = *(const f32x4*)(wp + (size_t)k * (6 * DM));
#pragma unroll
                    for (int b = 0; b < 8; ++b) acc[b] += cact[b * DM + ks * 128 + k] * w;
                }
#pragma unroll
                for (int b = 0; b < 8; ++b) *(LAS f32x4*)&red[(ks * 8 + b) * 96 + cg * 4] = acc[b];
            }
            __syncthreads();
            for (int o = tid; o < 768; o += 512) {
                const int b = o / 96, j = o % 96; float s = 0.f;
#pragma unroll
                for (int ks = 0; ks < 16; ++ks) s += red[(ks * 8 + b) * 96 + j];
                mod[((size_t)l * 8 + b) * (6 * DM) + j0 + j] = s + b_ada[l * 6 * DM + j0 + j];
            }
            __syncthreads();
        }
    }
    cvt_range(a, lds, tid, bx, G, NT_PRO, false);
}

template <int MODE>
__device__ __forceinline__ void norm_phase(const MkArgs& a, LAS unsigned char* lds, const int l, const int wv) {
    int tid = mk_tid(wv); asm volatile("" : "+v"(tid));
    const int G = gridDim.x, bx = blockIdx.x;
    const int w = __builtin_amdgcn_readfirstlane(tid >> 6), lane = tid & 63, r = lane & 15, q = lane >> 4;
    unsigned char* ws = a.ws;
    float* xcur = (float*)(ws + WS_X);
    bf16_t* hb = (bf16_t*)(ws + WS_H);
    const float* mod = (const float*)(ws + WS_MOD);
    LAS float* ssp = (LAS float*)lds;
    LAS float* part = (LAS float*)(lds + 1024);
    LAS float* lgt = (LAS float*)(lds + 1024 + 8 * 16 * 48 * 4);
    LAS int* rexp = (LAS int*)(lds + 28672);
    LAS int* lcnt = (LAS int*)(lds + 28672 + 512);
    LAS int* lbase = (LAS int*)(lds + 28672 + 640);
    LAS float* tabA = (LAS float*)(lds + 73728);
    LAS float* tabB = (LAS float*)(lds + 81920);
    LAS float* tabG = (LAS float*)(lds + 90112);
    if (MODE == 2 && tid < 32) lcnt[tid] = 0;
    const float* gain = (MODE == 3) ? a.in[18] : (MODE == 2 ? a.in[3] + l * DM : a.in[2] + l * DM);
    float carry = 0.f;
    for (int cb4 = bx * 4; cb4 < NTOK / 16; cb4 += G * 4)
    for (int rb = cb4; rb < cb4 + 4; ++rb) {
        const int t = rb * 16 + r, b = (rb * 16) / SEQ;
        const float* xsrc = (MODE == 0) ? a.in[0] : xcur;
        if (rb == cb4) {
            const int k4 = tid * 4;
            const f32x4 g4 = *(const f32x4*)(gain + k4);
            if constexpr (MODE != 3) {
                const float* sh_ = mod + ((size_t)l * 8 + b) * (6 * DM) + (MODE == 2 ? 3 * DM : 0);
                const f32x4 s4 = *(const f32x4*)(sh_ + k4), c4 = *(const f32x4*)(sh_ + DM + k4);
                *(LAS f32x4*)&tabA[k4] = (f32x4){g4[0] * (1.0f + c4[0]), g4[1] * (1.0f + c4[1]), g4[2] * (1.0f + c4[2]), g4[3] * (1.0f + c4[3])};
                *(LAS f32x4*)&tabB[k4] = s4;
            } else *(LAS f32x4*)&tabA[k4] = g4;
            if constexpr (MODE == 1 || MODE == 3) {
                const int lm_ = (MODE == 1) ? l - 1 : 1;
                *(LAS f32x4*)&tabG[k4] = *(const f32x4*)(mod + ((size_t)lm_ * 8 + b) * (6 * DM) + 5 * DM + k4);
            }
            __syncthreads();
        }
        float xv[64];
#pragma unroll
        for (int j = 0; j < 8; ++j) {
            const int k = 256 * w + 32 * j + 8 * q;
            const f32x4 v0 = *(const f32x4*)(xsrc + (size_t)t * DM + k), v1 = *(const f32x4*)(xsrc + (size_t)t * DM + k + 4);
            xv[8 * j + 0] = v0[0]; xv[8 * j + 1] = v0[1]; xv[8 * j + 2] = v0[2]; xv[8 * j + 3] = v0[3];
            xv[8 * j + 4] = v1[0]; xv[8 * j + 5] = v1[1]; xv[8 * j + 6] = v1[2]; xv[8 * j + 7] = v1[3];
        }
        if constexpr (MODE == 1 || MODE == 3) {
            const float* tokw = (const float*)(ws + WS_TOKW);
            const bf16_t* yb = (const bf16_t*)(ws + WS_YB);
            const float w0 = tokw[2 * t], w1 = tokw[2 * t + 1];
#pragma unroll
            for (int j = 0; j < 8; ++j) {
                const int k = 256 * w + 32 * j + 8 * q;
                const u32x4 y0 = *(const u32x4*)(yb + (size_t)(2 * t) * DM + k), y1 = *(const u32x4*)(yb + (size_t)(2 * t + 1) * DM + k);
                const f32x4 g0 = *(const LAS f32x4*)&tabG[k], g1 = *(const LAS f32x4*)&tabG[k + 4];
                xv[8 * j + 0] += g0[0] * (w0 * bf_lo(y0[0]) + w1 * bf_lo(y1[0])); xv[8 * j + 1] += g0[1] * (w0 * bf_hi(y0[0]) + w1 * bf_hi(y1[0]));
                xv[8 * j + 2] += g0[2] * (w0 * bf_lo(y0[1]) + w1 * bf_lo(y1[1])); xv[8 * j + 3] += g0[3] * (w0 * bf_hi(y0[1]) + w1 * bf_hi(y1[1]));
                xv[8 * j + 4] += g1[0] * (w0 * bf_lo(y0[2]) + w1 * bf_lo(y1[2])); xv[8 * j + 5] += g1[1] * (w0 * bf_hi(y0[2]) + w1 * bf_hi(y1[2]));
                xv[8 * j + 6] += g1[2] * (w0 * bf_lo(y0[3]) + w1 * bf_lo(y1[3])); xv[8 * j + 7] += g1[3] * (w0 * bf_hi(y0[3]) + w1 * bf_hi(y1[3]));
                if constexpr (MODE == 1) {
                    *(f32x4*)(xcur + (size_t)t * DM + k) = (f32x4){xv[8 * j + 0], xv[8 * j + 1], xv[8 * j + 2], xv[8 * j + 3]};
                    *(f32x4*)(xcur + (size_t)t * DM + k + 4) = (f32x4){xv[8 * j + 4], xv[8 * j + 5], xv[8 * j + 6], xv[8 * j + 7]};
                }
            }
        }
        float ss = 0.f;
#pragma unroll
        for (int i = 0; i < 64; ++i) ss += xv[i] * xv[i];
        ss += __shfl_xor(ss, 16); ss += __shfl_xor(ss, 32);
        if (q == 0) ssp[w * 16 + r] = ss;
        __syncthreads();
        float tot = 0.f;
#pragma unroll
        for (int i = 0; i < 8; ++i) tot += ssp[i * 16 + r];
        const float rstd = 1.0f / sqrtf(tot * (1.0f / DM) + EPSV);
#pragma unroll
        for (int j = 0; j < 8; ++j) {
            const int k = 256 * w + 32 * j + 8 * q;
            const f32x4 g0 = *(const LAS f32x4*)&tabA[k], g1 = *(const LAS f32x4*)&tabA[k + 4];
            float gg[8] = {g0[0], g0[1], g0[2], g0[3], g1[0], g1[1], g1[2], g1[3]};
            if constexpr (MODE != 3) {
                const f32x4 s0 = *(const LAS f32x4*)&tabB[k], s1 = *(const LAS f32x4*)&tabB[k + 4];
                const float sv[8] = {s0[0], s0[1], s0[2], s0[3], s1[0], s1[1], s1[2], s1[3]};
#pragma unroll
                for (int i = 0; i < 8; ++i) xv[8 * j + i] = (xv[8 * j + i] * rstd) * gg[i] + sv[i];
                u32x4 o; o[0] = cvt_pk_bf16(xv[8 * j + 0], xv[8 * j + 1]); o[1] = cvt_pk_bf16(xv[8 * j + 2], xv[8 * j + 3]);
                o[2] = cvt_pk_bf16(xv[8 * j + 4], xv[8 * j + 5]); o[3] = cvt_pk_bf16(xv[8 * j + 6], xv[8 * j + 7]);
                *(u32x4*)(hb + (size_t)t * DM + k) = o;
            } else {
#pragma unroll
                for (int i = 0; i < 8; ++i) xv[8 * j + i] = xv[8 * j + i] * rstd * gg[i];
                *(f32x4*)(a.out + (size_t)t * DM + k) = (f32x4){xv[8 * j + 0], xv[8 * j + 1], xv[8 * j + 2], xv[8 * j + 3]};
                *(f32x4*)(a.out + (size_t)t * DM + k + 4) = (f32x4){xv[8 * j + 4], xv[8 * j + 5], xv[8 * j + 6], xv[8 * j + 7]};
            }
        }
        if constexpr (MODE == 0 || MODE == 1) {
            const char* wb = (const char*)(ws + WS_WGAF) + ((size_t)l * 64 + w * 8) * 2 * 1024;
            unsigned lo16 = (unsigned)lane * 16u; asm volatile("" : "+v"(lo16));
#define WFRAG(i) (*(const u32x4*)(wb + (i) * 1024 + lo16))
            f32x4 acc = (f32x4){0.f, 0.f, 0.f, 0.f};
            u32x4 fr[16];
#pragma unroll
            for (int i = 0; i < 16; ++i) fr[i] = WFRAG(i);
#pragma unroll
            for (int j = 0; j < 8; ++j) {
                u32x4 ah, al;
#pragma unroll
                for (int e = 0; e < 4; ++e) { const unsigned hp = cvt_pk_bf16(xv[8 * j + 2 * e], xv[8 * j + 2 * e + 1]); ah[e] = hp;
                    al[e] = cvt_pk_bf16(xv[8 * j + 2 * e] - bf_lo(hp), xv[8 * j + 2 * e + 1] - bf_hi(hp)); }
                const u32x4 bh = fr[2 * j], bl = fr[2 * j + 1];
                acc = __builtin_amdgcn_mfma_f32_16x16x32_bf16(__builtin_bit_cast(bf16x8, ah), __builtin_bit_cast(bf16x8, bh), acc, 0, 0, 0);
                acc = __builtin_amdgcn_mfma_f32_16x16x32_bf16(__builtin_bit_cast(bf16x8, ah), __builtin_bit_cast(bf16x8, bl), acc, 0, 0, 0);
                acc = __builtin_amdgcn_mfma_f32_16x16x32_bf16(__builtin_bit_cast(bf16x8, al), __builtin_bit_cast(bf16x8, bh), acc, 0, 0, 0);
            }
#pragma unroll
            for (int e = 0; e < 4; ++e) part[(w * 16 + 4 * q + e) * 48 + r] = acc[e];
#undef WFRAG
            __syncthreads();
            {
                const float* w_gk = a.in[7] + (size_t)l * 16 * 512; const float* b_gk = a.in[8] + l * 512;
                float wr[16];
#pragma unroll
                for (int c = 0; c < 16; ++c) wr[c] = w_gk[c * 512 + tid];
                const float bz = b_gk[tid];
                LAS float* gs = (LAS float*)(lds + 32768);
                if (tid < 256) {
                    const int rr = tid >> 4, c = tid & 15; float s = 0.f;
#pragma unroll
                    for (int i = 0; i < 8; ++i) s += part[(i * 16 + rr) * 48 + c];
                    gs[tid] = s;
                }
                __syncthreads();
                float* bc = (float*)(ws + WS_LA);
                if ((rb & 3) == 0) carry = 0.f;
#pragma unroll
                for (int rr = 0; rr < 16; ++rr) {
                    const f32x4 g0 = *(const LAS f32x4*)&gs[rr * 16], g1 = *(const LAS f32x4*)&gs[rr * 16 + 4], g2 = *(const LAS f32x4*)&gs[rr * 16 + 8], g3 = *(const LAS f32x4*)&gs[rr * 16 + 12];
                    float z = bz;
#pragma unroll
                    for (int c = 0; c < 4; ++c) z += g0[c] * wr[c] + g1[c] * wr[4 + c] + g2[c] * wr[8 + c] + g3[c] * wr[12 + c];
                    const float ls = fminf(z, 0.f) - 0.6931471805599453f * __builtin_amdgcn_logf(1.0f + __builtin_amdgcn_exp2f(-fabsf(z) * 1.4426950408889634f));
                    carry += ls * (1.0f / 16.0f);
                    bc[(size_t)(rb * 16 + rr) * 512 + tid] = carry;
                }
            }
        }
        if constexpr (MODE == 2) {
            const char* wb = (const char*)(ws + WS_WRF) + ((size_t)l * 64 + w * 8) * 6 * 1024;
            unsigned lo16 = (unsigned)lane * 16u; asm volatile("" : "+v"(lo16));
#define WFRAG(i) (*(const u32x4*)(wb + (i) * 1024 + lo16))
            f32x4 acc[3];
#pragma unroll
            for (int nt = 0; nt < 3; ++nt) acc[nt] = (f32x4){0.f, 0.f, 0.f, 0.f};
            u32x4 frA[16], frB[16];
#define RT_LOAD(fr, c) do { _Pragma("unroll") for (int i = 0; i < 16; ++i) fr[i] = WFRAG((c) * 16 + i); } while (0)
#define RT_MMA(fr, c) do { _Pragma("unroll") for (int s = 0; s < 8; ++s) { \
                    const int st = (c) * 8 + s, j = st / 3, nt = st % 3; \
                    u32x4 ah, al; \
                    _Pragma("unroll") for (int e = 0; e < 4; ++e) { const unsigned hp = cvt_pk_bf16(xv[8 * j + 2 * e], xv[8 * j + 2 * e + 1]); ah[e] = hp; \
                        al[e] = cvt_pk_bf16(xv[8 * j + 2 * e] - bf_lo(hp), xv[8 * j + 2 * e + 1] - bf_hi(hp)); } \
                    const u32x4 bh = fr[2 * s], bl = fr[2 * s + 1]; \
                    acc[nt] = __builtin_amdgcn_mfma_f32_16x16x32_bf16(__builtin_bit_cast(bf16x8, ah), __builtin_bit_cast(bf16x8, bh), acc[nt], 0, 0, 0); \
                    acc[nt] = __builtin_amdgcn_mfma_f32_16x16x32_bf16(__builtin_bit_cast(bf16x8, ah), __builtin_bit_cast(bf16x8, bl), acc[nt], 0, 0, 0); \
                    acc[nt] = __builtin_amdgcn_mfma_f32_16x16x32_bf16(__builtin_bit_cast(bf16x8, al), __builtin_bit_cast(bf16x8, bh), acc[nt], 0, 0, 0); } } while (0)
            RT_LOAD(frA, 0); RT_LOAD(frB, 1);
            RT_MMA(frA, 0);
            RT_LOAD(frA, 2);
            RT_MMA(frB, 1);
            RT_MMA(frA, 2);
#undef RT_LOAD
#undef RT_MMA
#pragma unroll
            for (int nt = 0; nt < 3; ++nt)
#pragma unroll
                for (int e = 0; e < 4; ++e) part[(w * 16 + 4 * q + e) * 48 + 16 * nt + r] = acc[nt][e];
#undef WFRAG
            __syncthreads();
            for (int o = tid; o < 16 * 36; o += 512) {
                const int rr = o / 36, c = o % 36; float s = 0.f;
#pragma unroll
                for (int i = 0; i < 8; ++i) s += part[(i * 16 + rr) * 48 + c];
                lgt[o] = s + (c < 4 ? a.in[12][l * 4 + c] : a.in[14][l * 32 + c - 4]);
            }
            __syncthreads();
            if (tid < 16) {
                const LAS float* sl = lgt + tid * 36; const int tt = rb * 16 + tid;
                int grp = 0; float m = sl[0];
                for (int g = 1; g < 4; ++g) if (sl[g] > m) { m = sl[g]; grp = g; }
                float se = 0.f;
                for (int g = 0; g < 4; ++g) se += __builtin_amdgcn_exp2f((sl[g] - m) * 1.4426950408889634f);
                const float pg = 1.0f / se;
                const LAS float* lgp = sl + 4 + grp * 8;
                const f32x4 l0 = *(const LAS f32x4*)lgp, l1 = *(const LAS f32x4*)(lgp + 4);
                const float lv[8] = {l0[0], l0[1], l0[2], l0[3], l1[0], l1[1], l1[2], l1[3]};
                int i0 = 0; float v0 = lv[0];
#pragma unroll
                for (int jx = 1; jx < 8; ++jx) if (lv[jx] > v0) { v0 = lv[jx]; i0 = jx; }
                int i1 = -1; float v1 = 0.f;
#pragma unroll
                for (int jx = 0; jx < 8; ++jx) if (jx != i0 && (i1 < 0 || lv[jx] > v1)) { v1 = lv[jx]; i1 = jx; }
                const float e1 = __builtin_amdgcn_exp2f((v1 - v0) * 1.4426950408889634f);
                const float p0 = 1.0f / (1.0f + e1), p1 = e1 / (1.0f + e1);
                float* tokw = (float*)(ws + WS_TOKW);
                tokw[2 * tt] = pg * p0; tokw[2 * tt + 1] = pg * p1;
                const int ai = ((rb & 3) * 16 + tid) * 2;
                rexp[ai] = grp * 8 + i0; rexp[ai + 1] = grp * 8 + i1;
            }
            if ((rb & 3) == 3) {
                __syncthreads();
                int e = 0, rk = 0;
                if (tid < 128) { e = rexp[tid]; rk = __hip_atomic_fetch_add(&lcnt[e], 1, __ATOMIC_RELAXED, __HIP_MEMORY_SCOPE_WORKGROUP); }
                __syncthreads();
                if (tid < 32) { const int c = lcnt[tid]; int bs = 0; if (c > 0) bs = atomicAdd((int*)(ws + WS_CNT) + l * NEXP + tid, c); lbase[tid] = bs; lcnt[tid] = 0; }
                __syncthreads();
                if (tid < 128) { int* slot = (int*)(ws + WS_SLOT); slot[(size_t)e * ECAP + lbase[e] + rk] = 2 * ((rb & ~3) * 16 + (tid >> 1)) + (tid & 1); }
            }
        }
        __syncthreads();
    }
}

namespace pg8 {
constexpr int BM = 256, BK = 64, HALF = 128, HTB = HALF * BK * 2, STAGE_BYTES = 8 * HTB, NXCD = 8, WGM = 8;
__device__ __forceinline__ int lds_byte(int r, int c) { const int st = (r >> 4) * 2 + (c >> 5), rr = r & 15, cc = c & 31, ob = rr * 64 + cc * 2; return st * 1024 + (ob ^ (((ob >> 9) & 1) << 5)); }
__device__ __forceinline__ void stage_rc(int b, int& R, int& C) { const int st = b / 1024, sb = b % 1024, swz = sb ^ (((sb >> 9) & 1) << 5); R = (st >> 1) * 16 + swz / 64; C = (st & 1) * 32 + (swz % 64) / 2; }
__device__ __forceinline__ int perm32(int rho) { const int n = rho >> 4, i = rho & 15; return 8 * (i >> 2) + 4 * n + (i & 3); }
struct Unit { int pm, pn, e, rows, ui; };

struct DenseOrder {
    static constexpr bool GATHER = false;
    int nM, nN, nwg, G, c; const bf16_t* Bt; int K;
    __device__ __forceinline__ void init(int M, int N, int K_, const bf16_t* Bt_, int G_, int c_) { nM = M / BM; nN = N / BM; nwg = nM * nN; G = G_; c = c_; Bt = Bt_; K = K_; }
    __device__ __forceinline__ bool next(int i, Unit& u) const {
        const long L = (long)i * G + c; if (L >= nwg) return false;
        int wgid = (int)L; { const int q = nwg / NXCD, r = nwg % NXCD, xcd = wgid % NXCD, off = wgid / NXCD; wgid = (xcd < r ? xcd * (q + 1) : r * (q + 1) + (xcd - r) * q) + off; }
        const int nig = WGM * nN, gid = wgid / nig, fm = gid * WGM, gsz = (nM - fm) < WGM ? (nM - fm) : WGM;
        u.pm = fm + ((wgid % nig) % gsz); u.pn = (wgid % nig) / gsz; u.e = 0; u.rows = 256; u.ui = i; return true;
    }
    __device__ __forceinline__ const char* bptr(const Unit& u) const { return (const char*)Bt + (size_t)u.pn * 256 * K * 2; }
    __device__ __forceinline__ unsigned arow(const Unit& u, int r) const { return (unsigned)(u.pm * 256 + r); }
};

#define PG8_SA(b, h) (((b) * 2 + (h)) * HTB)
#define PG8_SB(b, h) ((4 + (b) * 2 + (h)) * HTB)
#define PG8_STAGE(bufoff, gbase, voff) do { _Pragma("unroll") for (int _i = 0; _i < 2; ++_i) \
        __builtin_amdgcn_global_load_lds((const unsigned*)((const char*)(gbase) + (voff)[_i]), (LAS unsigned*)(lds + (bufoff) + ldsw + _i * 8192), 16, 0, 0); } while (0)
#define PG8_LDA(dst, b, h) do { _Pragma("unroll") for (int m = 0; m < 4; ++m) _Pragma("unroll") for (int k = 0; k < 2; ++k) dst[m][k] = *(const LAS bf16x8*)(lds + PG8_SA(b, h) + aoff + m * 2048 + k * 1024); } while (0)
#define PG8_LDB(dst, b, h) do { _Pragma("unroll") for (int n = 0; n < 2; ++n) _Pragma("unroll") for (int k = 0; k < 2; ++k) dst[n][k] = *(const LAS bf16x8*)(lds + PG8_SB(b, h) + boff + n * 2048 + k * 1024); } while (0)
#define PG8_MMA(ai, bj, At, Bt) do { __builtin_amdgcn_s_setprio(1); _Pragma("unroll") for (int m = 0; m < 4; ++m) _Pragma("unroll") for (int n = 0; n < 2; ++n) _Pragma("unroll") for (int k = 0; k < 2; ++k) \
        acc[ai][bj][m][n] = __builtin_amdgcn_mfma_f32_16x16x32_bf16(Bt[n][k], At[m][k], acc[ai][bj][m][n], 0, 0, 0); __builtin_amdgcn_s_setprio(0); } while (0)
#define PG8_WAIT_V(n) asm volatile("s_waitcnt vmcnt(" #n ")" ::: "memory")
#define PG8_WAIT_L(n) asm volatile("s_waitcnt lgkmcnt(" #n ")" ::: "memory")
#define PG8_BAR __builtin_amdgcn_s_barrier()
#define PG8_SCHED __builtin_amdgcn_sched_barrier(0)

#define PG8_STAGE_A(bufoff, h, nextu, kofs) do { \
        if constexpr (Sched::GATHER) { const char* _g = Ab + (kofs); unsigned _x[2]; \
            _x[0] = (nextu) ? ((h) ? no1[0] : no0[0]) : ((h) ? ao1[0] : ao0[0]); _x[1] = (nextu) ? ((h) ? no1[1] : no0[1]) : ((h) ? ao1[1] : ao0[1]); PG8_STAGE(bufoff, _g, _x); } \
        else { const char* _g = ((nextu) ? nA : cA) + (size_t)(h) * hstep + (kofs); PG8_STAGE(bufoff, _g, voffA); } } while (0)
template <class Epi, class Sched>
__device__ __forceinline__ void gemm_phase(LAS unsigned char* lds, const bf16_t* A, const int K, const Sched& S, const Epi& E, const int wv) {
    int tid = mk_tid(wv); asm volatile("" : "+v"(tid));
    const int wid = __builtin_amdgcn_readfirstlane(tid >> 6), lane = tid & 63, wr = wid >> 2, wc = wid & 3, fr = lane & 15, fq = lane >> 4;
    const int nt = K / BK;
    unsigned voffA[2], voffB[2];
#pragma unroll
    for (int i = 0; i < 2; ++i) { int R, C; stage_rc(tid * 16 + i * 8192, R, C); const int Rb = Epi::PERM ? ((R & ~31) + perm32(R & 31)) : R;
        voffA[i] = (unsigned)(R * K + C) * 2u; voffB[i] = (unsigned)(Rb * K + C) * 2u; }
    const size_t kstep = (size_t)(BK * 2);
    const size_t hstep = (size_t)HALF * K * 2;
    const size_t tstep = 2 * hstep;
    const unsigned ldsw = (unsigned)wid * 1024u;
    const int aoff = lds_byte(wr * 64 + fr, fq * 8), boff = lds_byte(wc * 32 + fr, fq * 8);
    Unit cur, nxt; int ui = 0;
    if (!S.next(0, cur)) return;
    f32x4 acc[2][2][4][2];
#pragma unroll
    for (int a_ = 0; a_ < 2; ++a_)
#pragma unroll
        for (int b_ = 0; b_ < 2; ++b_)
#pragma unroll
            for (int m = 0; m < 4; ++m)
#pragma unroll
                for (int n = 0; n < 2; ++n) acc[a_][b_][m][n] = (f32x4){0.f, 0.f, 0.f, 0.f};
    bf16x8 At[4][2], B0[2][2], B1[2][2];
    unsigned ao0[2] = {0u, 0u}, ao1[2] = {0u, 0u}, no0[2] = {0u, 0u}, no1[2] = {0u, 0u};
    const char* Ab = (const char*)A;
    const char* cA = Ab; const char* nA = Ab;
    if constexpr (Sched::GATHER) {
#pragma unroll
        for (int i = 0; i < 2; ++i) { int R, C; stage_rc(tid * 16 + i * 8192, R, C);
            ao0[i] = (S.arow(cur, R) * (unsigned)K + (unsigned)C) * 2u; ao1[i] = (S.arow(cur, HALF + R) * (unsigned)K + (unsigned)C) * 2u; }
    } else cA = Ab + (size_t)cur.pm * tstep;
    const char* cB = S.bptr(cur);
    PG8_STAGE(PG8_SB(0, 0), cB, voffB); PG8_STAGE_A(PG8_SA(0, 0), 0, false, 0); PG8_STAGE(PG8_SB(0, 1), cB + hstep, voffB); PG8_STAGE_A(PG8_SA(0, 1), 1, false, 0);
    if (wr == 1) PG8_BAR;
    PG8_WAIT_V(4); PG8_BAR;
    PG8_STAGE(PG8_SB(1, 0), cB + kstep, voffB); PG8_STAGE_A(PG8_SA(1, 0), 0, false, kstep); PG8_STAGE(PG8_SB(1, 1), cB + hstep + kstep, voffB);
    PG8_WAIT_V(6); PG8_BAR;
    for (;;) {
        const bool has_next = S.next(ui + 1, nxt);
        const char* nB = has_next ? S.bptr(nxt) : cB;
        if constexpr (Sched::GATHER) {
            if (has_next) {
#pragma unroll
                for (int i = 0; i < 2; ++i) { int R, C; stage_rc(tid * 16 + i * 8192, R, C);
                    no0[i] = (S.arow(nxt, R) * (unsigned)K + (unsigned)C) * 2u; no1[i] = (S.arow(nxt, HALF + R) * (unsigned)K + (unsigned)C) * 2u; }
            } else {
#pragma unroll
                for (int i = 0; i < 2; ++i) { no0[i] = ao0[i]; no1[i] = ao1[i]; }
            }
            asm volatile("s_waitcnt lgkmcnt(0)" ::: "memory");
            asm volatile("" : "+v"(no0[0]), "+v"(no0[1]), "+v"(no1[0]), "+v"(no1[1]));
        } else nA = has_next ? Ab + (size_t)nxt.pm * tstep : cA;
        for (int t = 0; t < nt; t += 2) {
            const bool last = (t == nt - 2);
            const size_t k1 = (size_t)(t + 1) * kstep;
            const size_t k2 = last ? 0 : (size_t)(t + 2) * kstep, k3 = k2 + kstep;
            const char* b2 = last ? nB : cB + (size_t)(t + 2) * kstep; const char* b3 = b2 + kstep;
            PG8_LDB(B0, 0, 0); PG8_SCHED; PG8_LDA(At, 0, 0); PG8_STAGE_A(PG8_SA(1, 1), 1, false, k1);
            PG8_WAIT_L(8); PG8_BAR; PG8_WAIT_L(0); PG8_MMA(0, 0, At, B0); PG8_BAR; PG8_SCHED;
            PG8_LDB(B1, 0, 1); PG8_STAGE(PG8_SB(0, 0), b2, voffB);
            PG8_BAR; PG8_WAIT_L(0); PG8_MMA(0, 1, At, B1); PG8_BAR;
            PG8_LDA(At, 0, 1); PG8_STAGE_A(PG8_SA(0, 0), 0, last, k2);
            PG8_BAR; PG8_WAIT_L(0); PG8_MMA(1, 0, At, B0); PG8_BAR; PG8_SCHED;
            PG8_STAGE(PG8_SB(0, 1), b2 + hstep, voffB);
            PG8_WAIT_V(6); PG8_BAR; PG8_MMA(1, 1, At, B1); PG8_BAR;
            PG8_LDB(B0, 1, 0); PG8_SCHED; PG8_LDA(At, 1, 0); PG8_STAGE_A(PG8_SA(0, 1), 1, last, k2);
            PG8_WAIT_L(8); PG8_BAR; PG8_WAIT_L(0); PG8_MMA(0, 0, At, B0); PG8_BAR; PG8_SCHED;
            PG8_LDB(B1, 1, 1); PG8_STAGE(PG8_SB(1, 0), b3, voffB);
            PG8_BAR; PG8_WAIT_L(0); PG8_MMA(0, 1, At, B1); PG8_BAR;
            PG8_LDA(At, 1, 1); PG8_STAGE_A(PG8_SA(1, 0), 0, last, k3);
            PG8_BAR; PG8_WAIT_L(0); PG8_MMA(1, 0, At, B0); PG8_BAR; PG8_SCHED;
            PG8_STAGE(PG8_SB(1, 1), b3 + hstep, voffB);
            PG8_WAIT_V(6); PG8_BAR; PG8_MMA(1, 1, At, B1); PG8_BAR;
        }
        E(acc, cur, wr, wc, fr, fq);
        if (!has_next) break;
#pragma unroll
        for (int a_ = 0; a_ < 2; ++a_)
#pragma unroll
            for (int b_ = 0; b_ < 2; ++b_)
#pragma unroll
                for (int m = 0; m < 4; ++m)
#pragma unroll
                    for (int n = 0; n < 2; ++n) acc[a_][b_][m][n] = (f32x4){0.f, 0.f, 0.f, 0.f};
        cur = nxt; cB = nB; cA = nA; ++ui;
#pragma unroll
        for (int i = 0; i < 2; ++i) { ao0[i] = no0[i]; ao1[i] = no1[i]; }
    }
    PG8_WAIT_V(0);
    if (wr == 0) PG8_BAR;
    PG8_BAR;
}

struct EpiInProj {
    static constexpr bool PERM = true;
    unsigned char* ws; float* kmean; const float* rope; const float* bcum;
    __device__ __forceinline__ void operator()(const f32x4 (&acc)[2][2][4][2], const Unit& u, int wr, int wc, int fr, int fq) const {
        const int row0 = u.pm * BM + wr * 64 + fr;
        const int lc = wc * 32 + 8 * fq;
        if (u.pn < 8) {
            const bool isq = u.pn < 4;
            bf16_t* dst = (bf16_t*)(ws + (isq ? WS_Q : WS_K));
            const int cb = (u.pn & 3) * 256;
            const float scale = isq ? QSCALE : 1.0f;
            float ks[2][8];
#pragma unroll
            for (int bj = 0; bj < 2; ++bj)
#pragma unroll
                for (int i = 0; i < 8; ++i) ks[bj][i] = 0.f;
            f32x4 rc[2][4];
#define ROPE_LOAD(buf, g) do { const int _pos = (row0 + ((g) >> 2) * HALF + ((g) & 3) * 16) & (SEQ - 1); const float* _rp = rope + _pos * 32 + 8 * (fq & 1); \
                rc[buf][0] = *(const f32x4*)_rp; rc[buf][1] = *(const f32x4*)(_rp + 4); rc[buf][2] = *(const f32x4*)(_rp + 16); rc[buf][3] = *(const f32x4*)(_rp + 20); } while (0)
            if (wc == 0) ROPE_LOAD(0, 0);
#pragma unroll
            for (int g = 0; g < 8; ++g) {
                const int ai = g >> 2, m = g & 3;
                const int r = row0 + ai * HALF + m * 16;
                if (wc == 0 && g + 1 < 8) ROPE_LOAD((g + 1) & 1, g + 1);
#pragma unroll
                for (int bj = 0; bj < 2; ++bj) {
                    float v[8] = {acc[ai][bj][m][0][0], acc[ai][bj][m][0][1], acc[ai][bj][m][0][2], acc[ai][bj][m][0][3],
                                  acc[ai][bj][m][1][0], acc[ai][bj][m][1][1], acc[ai][bj][m][1][2], acc[ai][bj][m][1][3]};
                    if (wc == 0) {
                        const f32x4 c0 = rc[g & 1][0], c1 = rc[g & 1][1], s0 = rc[g & 1][2], s1 = rc[g & 1][3];
                        const float cs[8] = {c0[0], c0[1], c0[2], c0[3], c1[0], c1[1], c1[2], c1[3]}, sn[8] = {s0[0], s0[1], s0[2], s0[3], s1[0], s1[1], s1[2], s1[3]};
#pragma unroll
                        for (int i = 0; i < 8; ++i) {
                            const float pv = __shfl_xor(v[i], 32);
                            v[i] = (fq < 2) ? (v[i] * cs[i] - pv * sn[i]) : (v[i] * cs[i] + pv * sn[i]);
                        }
                    }
                    if (!isq) {
#pragma unroll
                        for (int i = 0; i < 8; ++i) ks[bj][i] += v[i];
                    }
                    u32x4 o; o[0] = cvt_pk_bf16(v[0] * scale, v[1] * scale); o[1] = cvt_pk_bf16(v[2] * scale, v[3] * scale);
                    o[2] = cvt_pk_bf16(v[4] * scale, v[5] * scale); o[3] = cvt_pk_bf16(v[6] * scale, v[7] * scale);
                    __builtin_nontemporal_store(o, (u32x4*)(dst + ((size_t)((r >> 11) * 8 + (u.pn & 3) * 2 + bj) * SEQ + (r & (SEQ - 1))) * 128 + lc));
                }
            }
#undef ROPE_LOAD
            if (!isq) {
                const int b = u.pm >> 3, blk = u.pm & 7;
#pragma unroll
                for (int bj = 0; bj < 2; ++bj) {
                    const int h = (u.pn & 3) * 2 + bj;
#pragma unroll
                    for (int i = 0; i < 8; ++i) {
                        float s = ks[bj][i];
                        s += __shfl_xor(s, 1); s += __shfl_xor(s, 2); s += __shfl_xor(s, 4); s += __shfl_xor(s, 8);
                        if (fr == 0) atomicAdd(kmean + (((size_t)b * 8 + h) * 8 + blk) * 128 + lc + i, s * (1.0f / 256.0f));
                    }
                }
            }
        } else if (u.pn < 12) {
            bf16_t* dst = (bf16_t*)(ws + WS_VT);
#pragma unroll
            for (int ai = 0; ai < 2; ++ai)
#pragma unroll
                for (int m = 0; m < 4; ++m) {
                    const int r = row0 + ai * HALF + m * 16;
#pragma unroll
                    for (int bj = 0; bj < 2; ++bj) {
                        const f32x4 v0 = acc[ai][bj][m][0], v1 = acc[ai][bj][m][1];
                        u32x4 o; o[0] = cvt_pk_bf16(v0[0], v0[1]); o[1] = cvt_pk_bf16(v0[2], v0[3]); o[2] = cvt_pk_bf16(v1[0], v1[1]); o[3] = cvt_pk_bf16(v1[2], v1[3]);
                        __builtin_nontemporal_store(o, (u32x4*)(dst + ((size_t)((r >> 11) * 8 + (u.pn - 8) * 2 + bj) * SEQ + (r & (SEQ - 1))) * 128 + lc));
                    }
                }
        } else if (u.pn < 16) {
            const bool isq = u.pn < 14;
            const int cb = (u.pn - (isq ? 12 : 14)) * 256;
            bf16_t* d0 = (bf16_t*)(ws + (isq ? WS_QG : WS_KG));
            f32x4 bc[2][2];
#define BC_LOAD(buf, g) do { const int _r = row0 + ((g) >> 3) * HALF + (((g) >> 1) & 3) * 16, _col = cb + ((g) & 1) * HALF + lc; \
                bc[buf][0] = *(const f32x4*)(bcum + (size_t)_r * 512 + _col); bc[buf][1] = *(const f32x4*)(bcum + (size_t)_r * 512 + _col + 4); } while (0)
            BC_LOAD(0, 0);
#pragma unroll
            for (int g = 0; g < 16; ++g) {
                const int ai = g >> 3, m = (g >> 1) & 3, bj = g & 1;
                const int r = row0 + ai * HALF + m * 16;
                if (g + 1 < 16) BC_LOAD((g + 1) & 1, g + 1);
                {
                    {
                        const int col = cb + bj * HALF + lc;
                        const size_t hoff = ((size_t)((r >> 11) * 4 + (col >> 7)) * SEQ + (r & (SEQ - 1))) * 128 + (col & 127);
                        const f32x4 b0 = bc[g & 1][0], b1 = bc[g & 1][1];
                        const f32x4 v0 = acc[ai][bj][m][0], v1 = acc[ai][bj][m][1];
                        const float L2E = 1.4426950408889634f;
                        if (isq) {
                            const float s = 0.08838834764831845f;
                            u32x4 o; o[0] = cvt_pk_bf16(v0[0] * s * __builtin_amdgcn_exp2f(b0[0] * L2E), v0[1] * s * __builtin_amdgcn_exp2f(b0[1] * L2E));
                            o[1] = cvt_pk_bf16(v0[2] * s * __builtin_amdgcn_exp2f(b0[2] * L2E), v0[3] * s * __builtin_amdgcn_exp2f(b0[3] * L2E));
                            o[2] = cvt_pk_bf16(v1[0] * s * __builtin_amdgcn_exp2f(b1[0] * L2E), v1[1] * s * __builtin_amdgcn_exp2f(b1[1] * L2E));
                            o[3] = cvt_pk_bf16(v1[2] * s * __builtin_amdgcn_exp2f(b1[2] * L2E), v1[3] * s * __builtin_amdgcn_exp2f(b1[3] * L2E));
                            __builtin_nontemporal_store(o, (u32x4*)(d0 + hoff));
                        } else {
                            u32x4 o;
                            o[0] = cvt_pk_bf16(v0[0] * __builtin_amdgcn_exp2f(-b0[0] * L2E), v0[1] * __builtin_amdgcn_exp2f(-b0[1] * L2E));
                            o[1] = cvt_pk_bf16(v0[2] * __builtin_amdgcn_exp2f(-b0[2] * L2E), v0[3] * __builtin_amdgcn_exp2f(-b0[3] * L2E));
                            o[2] = cvt_pk_bf16(v1[0] * __builtin_amdgcn_exp2f(-b1[0] * L2E), v1[1] * __builtin_amdgcn_exp2f(-b1[1] * L2E));
                            o[3] = cvt_pk_bf16(v1[2] * __builtin_amdgcn_exp2f(-b1[2] * L2E), v1[3] * __builtin_amdgcn_exp2f(-b1[3] * L2E));
                            __builtin_nontemporal_store(o, (u32x4*)(d0 + hoff));
                        }
                    }
                }
            }
#undef BC_LOAD
        } else {
            const bool isog = u.pn >= 20;
            size_t woff; int cb;
            if (u.pn < 20) { woff = WS_VG; cb = (u.pn - 16) * 256; }
            else { woff = WS_OG; cb = (u.pn - 20) * 256; }
            bf16_t* dst = (bf16_t*)(ws + woff);
#pragma unroll
            for (int ai = 0; ai < 2; ++ai)
#pragma unroll
                for (int m = 0; m < 4; ++m) {
                    const int r = row0 + ai * HALF + m * 16;
#pragma unroll
                    for (int bj = 0; bj < 2; ++bj) {
                        f32x4 v0 = acc[ai][bj][m][0], v1 = acc[ai][bj][m][1];
                        if (isog) {
#pragma unroll
                            for (int i = 0; i < 4; ++i) { v0[i] = silu_fast(v0[i]); v1[i] = silu_fast(v1[i]); }
                        }
                        u32x4 o; o[0] = cvt_pk_bf16(v0[0], v0[1]); o[1] = cvt_pk_bf16(v0[2], v0[3]); o[2] = cvt_pk_bf16(v1[0], v1[1]); o[3] = cvt_pk_bf16(v1[2], v1[3]);
                        __builtin_nontemporal_store(o, (u32x4*)(dst + ((size_t)((r >> 11) * 4 + (cb >> 8)) * SEQ + (r & (SEQ - 1))) * 256 + bj * HALF + lc));
                    }
                }
        }
    }
};
struct EpiResGate {
    static constexpr bool PERM = false;
    const float* res; float* out; const float* gate;
    __device__ __forceinline__ void operator()(const f32x4 (&acc)[2][2][4][2], const Unit& u, int wr, int wc, int fr, int fq) const {
        const int row0 = u.pm * BM + wr * 64 + fr, col0 = u.pn * BM + wc * 32 + 4 * fq;
        const int b = u.pm >> 3;
        f32x4 gv[2][2];
#pragma unroll
        for (int bj = 0; bj < 2; ++bj)
#pragma unroll
            for (int n = 0; n < 2; ++n) gv[bj][n] = *(const f32x4*)(gate + (size_t)b * (6 * DM) + col0 + bj * HALF + n * 16);
#pragma unroll
        for (int ai = 0; ai < 2; ++ai) {
            f32x4 rv[4][2][2];
#pragma unroll
            for (int m = 0; m < 4; ++m) { const size_t off = (size_t)(row0 + ai * HALF + m * 16) * DM + col0;
#pragma unroll
                for (int bj = 0; bj < 2; ++bj)
#pragma unroll
                    for (int n = 0; n < 2; ++n) rv[m][bj][n] = *(const f32x4*)(res + off + bj * HALF + n * 16); }
#pragma unroll
            for (int m = 0; m < 4; ++m) { const size_t off = (size_t)(row0 + ai * HALF + m * 16) * DM + col0;
#pragma unroll
                for (int bj = 0; bj < 2; ++bj)
#pragma unroll
                    for (int n = 0; n < 2; ++n) *(f32x4*)(out + off + bj * HALF + n * 16) = rv[m][bj][n] + gv[bj][n] * acc[ai][bj][m][n]; }
            asm volatile("" ::: "memory");
        }
    }
};
struct MoeOrder {
    static constexpr bool GATHER = true;
    const int* slot; const bf16_t* Bt; int K, G, c, a_shift; const LAS int* tb;
    LAS int* rowtab;
    __device__ __forceinline__ bool next(int i, Unit& u) const {
        const int L = i * G + c, total = tb[32] * 8; if (L >= total || i >= 8) return false;
        const int mt = L >> 3; int e = 0;
        for (int j = 1; j < 32; ++j) e = (tb[j] <= mt) ? j : e;
        e = __builtin_amdgcn_readfirstlane(e);
        u.e = e; u.pm = mt - tb[e]; u.pn = L & 7; u.ui = i;
        const int rem = tb[33 + e] - u.pm * 256; u.rows = rem < 256 ? rem : 256; return true;
    }
    __device__ __forceinline__ const char* bptr(const Unit& u) const { return (const char*)Bt + ((size_t)u.e * 2048 + (size_t)u.pn * 256) * K * 2; }
    __device__ __forceinline__ unsigned arow(const Unit& u, int r) const { return (unsigned)(rowtab[u.ui * 256 + r] >> a_shift); }
    __device__ __forceinline__ void fill_rows(const int tid) const {
        Unit u;
        for (int i = 0; i < 8 && next(i, u); ++i)
            if (tid < 256) rowtab[i * 256 + tid] = slot[(size_t)u.e * ECAP + u.pm * 256 + (tid < u.rows ? tid : 0)];
        __syncthreads();
    }
};
__device__ __forceinline__ void moe_tiles(const int* cnt, LAS int* tb, const int wv) {
    if (mk_tid(wv) == 0) { int acc = 0; for (int e = 0; e < 32; ++e) { const int c = cnt[e]; tb[e] = acc; tb[33 + e] = c; acc += (c + 255) >> 8; } tb[32] = acc; }
    __syncthreads();
}
struct EpiMoe1 {
    static constexpr bool PERM = true;
    const LAS int* rowtab; bf16_t* act;
    __device__ __forceinline__ void operator()(const f32x4 (&acc)[2][2][4][2], const Unit& u, int wr, int wc, int fr, int fq) const {
        const int lc = u.pn * 128 + wc * 32 + 8 * fq;
#pragma unroll
        for (int ai = 0; ai < 2; ++ai)
#pragma unroll
            for (int m = 0; m < 4; ++m) {
                const int r = ai * HALF + wr * 64 + m * 16 + fr;
                if (r < u.rows) {
                    const int asg = rowtab[u.ui * 256 + r];
                    float o[8];
#pragma unroll
                    for (int n = 0; n < 2; ++n)
#pragma unroll
                        for (int j = 0; j < 4; ++j) { const float g = acc[ai][0][m][n][j], up = acc[ai][1][m][n][j]; o[4 * n + j] = silu_fast(g) * up; }
                    u32x4 w; w[0] = cvt_pk_bf16(o[0], o[1]); w[1] = cvt_pk_bf16(o[2], o[3]); w[2] = cvt_pk_bf16(o[4], o[5]); w[3] = cvt_pk_bf16(o[6], o[7]);
                    *(u32x4*)(act + (size_t)asg * DEXP + lc) = w;
                }
            }
    }
};
struct EpiMoe2 {
    static constexpr bool PERM = true;
    const LAS int* rowtab; bf16_t* yb;
    __device__ __forceinline__ void operator()(const f32x4 (&acc)[2][2][4][2], const Unit& u, int wr, int wc, int fr, int fq) const {
        const int lc = u.pn * 256 + wc * 32 + 8 * fq;
#pragma unroll
        for (int ai = 0; ai < 2; ++ai)
#pragma unroll
            for (int m = 0; m < 4; ++m) {
                const int r = ai * HALF + wr * 64 + m * 16 + fr;
                if (r < u.rows) {
                    const int asg = rowtab[u.ui * 256 + r];
#pragma unroll
                    for (int bj = 0; bj < 2; ++bj) {
                        const f32x4 v0 = acc[ai][bj][m][0], v1 = acc[ai][bj][m][1];
                        u32x4 w; w[0] = cvt_pk_bf16(v0[0], v0[1]); w[1] = cvt_pk_bf16(v0[2], v0[3]); w[2] = cvt_pk_bf16(v1[0], v1[1]); w[3] = cvt_pk_bf16(v1[2], v1[3]);
                        *(u32x4*)(yb + (size_t)asg * DM + lc + bj * HALF) = w;
                    }
                }
            }
    }
};
}

namespace attn {
typedef float f32x16 __attribute__((ext_vector_type(16)));
typedef short s16x4 __attribute__((ext_vector_type(4)));
constexpr int KSTR = 272, VSTR = 320, KT_BYTES = 64 * KSTR, VT_BYTES = 64 * VSTR;
constexpr int L_KM = 0, L_K = 4096, L_V = L_K + 2 * KT_BYTES, L_END = L_V + 2 * VT_BYTES;

__device__ __forceinline__ float bf2f(short s) { return __uint_as_float(((unsigned)(unsigned short)s) << 16); }

__device__ __forceinline__ void attn_unit(LAS unsigned char* lds, const bf16_t* Q, const bf16_t* K, const bf16_t* Vt, const float* kmean, bf16_t* mix,
                                          const int b, const int h, const int blk, const int wv) {
    int tid = mk_tid(wv); asm volatile("" : "+v"(tid));
    const int w = __builtin_amdgcn_readfirstlane(tid >> 6), lane = tid & 63, j = lane & 31, hh = lane >> 5;
    LAS float* km = (LAS float*)(lds + L_KM);
    __syncthreads();
    {
        const float* kp = kmean + ((size_t)(b * 8 + h) * 8) * 128;
        km[2 * tid] = kp[2 * tid]; km[2 * tid + 1] = kp[2 * tid + 1];
    }
    const size_t qrow = (size_t)b * SEQ + blk * 256 + 32 * w + j;
    const size_t hbase = (size_t)(b * 8 + h) * SEQ;
    bf16x8 qf[8];
#pragma unroll
    for (int ks = 0; ks < 8; ++ks) qf[ks] = *(const bf16x8*)(Q + (hbase + blk * 256 + 32 * w + j) * 128 + 16 * ks + 8 * hh);
    const int ntile = 4 + 4 * blk;
    u32x4 krA[2], vrA[2], krB[2], vrB[2];
#define ATT_KEY0(ti) (((ti) < 4) ? (blk * 256 + 64 * (ti)) : ((((ti) - 4) >> 2) * 256 + 64 * (((ti) - 4) & 3)))
#define ATT_LOAD(kr, vr, ti) do { const int _k0 = ATT_KEY0(ti); _Pragma("unroll") for (int _i = 0; _i < 2; ++_i) { const int _c = tid + 512 * _i; \
        kr[_i] = *(const u32x4*)(K + (hbase + _k0) * 128 + (size_t)_c * 8); \
        vr[_i] = *(const u32x4*)(Vt + (hbase + _k0) * 128 + (size_t)_c * 8); } } while (0)
#define ATT_STORE(kr, vr, buf) do { _Pragma("unroll") for (int _i = 0; _i < 2; ++_i) { const int _c = tid + 512 * _i; \
        *(LAS u32x4*)(lds + L_K + (buf) * KT_BYTES + (_c >> 4) * KSTR + (_c & 15) * 16) = kr[_i]; \
        *(LAS u32x4*)(lds + L_V + (buf) * VT_BYTES + (_c >> 4) * VSTR + (_c & 15) * 16) = vr[_i]; } } while (0)
    ATT_LOAD(krA, vrA, 0);
    __syncthreads();
    unsigned sel = 0u;
    {
        float g[7];
#pragma unroll
        for (int n = 0; n < 7; ++n) {
            float p = 0.f;
            if (n < blk) {
#pragma unroll
                for (int ks = 0; ks < 8; ++ks) {
                    const f32x4 k0 = *(const LAS f32x4*)&km[n * 128 + 16 * ks + 8 * hh], k1 = *(const LAS f32x4*)&km[n * 128 + 16 * ks + 8 * hh + 4];
                    p += bf2f(qf[ks][0]) * k0[0] + bf2f(qf[ks][1]) * k0[1] + bf2f(qf[ks][2]) * k0[2] + bf2f(qf[ks][3]) * k0[3]
                       + bf2f(qf[ks][4]) * k1[0] + bf2f(qf[ks][5]) * k1[1] + bf2f(qf[ks][6]) * k1[2] + bf2f(qf[ks][7]) * k1[3];
                }
            }
            g[n] = p + __shfl_xor(p, 32);
        }
#pragma unroll
        for (int n = 0; n < 7; ++n) {
            int rank = 0;
#pragma unroll
            for (int m2 = 0; m2 < 7; ++m2) if (m2 != n && m2 < blk) rank += (g[m2] > g[n] || (g[m2] == g[n] && m2 < n)) ? 1 : 0;
            if (n < blk && rank < 3) sel |= 1u << n;
        }
    }
    ATT_STORE(krA, vrA, 0);
    if (ntile > 1) ATT_LOAD(krA, vrA, 1);
    __syncthreads();
    f32x16 o[4];
#pragma unroll
    for (int d = 0; d < 4; ++d)
#pragma unroll
        for (int r = 0; r < 16; ++r) o[d][r] = 0.f;
    float mrun = -1e30f, lsum = 0.f;
#define ATT_TILE(TI, KX, VX, KY, VY) do { const int ti = (TI); \
        const int buf = ti & 1; \
        if (ti + 2 < ntile) ATT_LOAD(KY, VY, ti + 2); \
        bool active, diag = false, lsel = true; \
        if (ti < 4) { active = (ti <= (w >> 1)); diag = (ti == (w >> 1)); } \
        else { lsel = ((sel >> ((ti - 4) >> 2)) & 1u) != 0u; active = __builtin_amdgcn_ballot_w64(lsel) != 0ull; } \
        if (active) { \
            f32x16 s0, s1; \
_Pragma("unroll") \
            for (int r = 0; r < 16; ++r) { s0[r] = 0.f; s1[r] = 0.f; } \
            const LAS unsigned char* kb = lds + L_K + buf * KT_BYTES + j * KSTR + hh * 16; \
_Pragma("unroll") \
            for (int ks = 0; ks < 8; ++ks) { \
                const bf16x8 a0 = *(const LAS bf16x8*)(kb + ks * 32), a1 = *(const LAS bf16x8*)(kb + 32 * KSTR + ks * 32); \
                s0 = __builtin_amdgcn_mfma_f32_32x32x16_bf16(a0, qf[ks], s0, 0, 0, 0); \
                s1 = __builtin_amdgcn_mfma_f32_32x32x16_bf16(a1, qf[ks], s1, 0, 0, 0); \
            } \
            const LAS unsigned char* vb = lds + L_V + buf * VT_BYTES + (((lane & 15) >> 2) + 4 * hh) * VSTR + (16 * ((lane >> 4) & 1) + 4 * (lane & 3)) * 2; \
_Pragma("unroll") \
            for (int u = 0; u < 2; ++u) { \
                f32x16& sx = u ? s1 : s0; \
                if (diag) { \
                    const int ql = 32 * w + j - 64 * ti - 32 * u; \
_Pragma("unroll") \
                    for (int r = 0; r < 16; ++r) { const int kr_ = (r & 3) + 8 * (r >> 2) + 4 * hh; if (kr_ > ql) sx[r] = -INFINITY; } \
                } \
                if (!lsel) { \
_Pragma("unroll") \
                    for (int r = 0; r < 16; ++r) sx[r] = -INFINITY; \
                } \
                float mnew = mrun, alpha = 1.0f; \
                if (ti < 4) { \
                    float mx = sx[0]; \
_Pragma("unroll") \
                    for (int r = 1; r < 16; ++r) mx = fmaxf(mx, sx[r]); \
                    mx = fmaxf(mx, __shfl_xor(mx, 32)); \
                    mnew = fmaxf(mrun, mx); alpha = __builtin_amdgcn_exp2f(mrun - mnew); mrun = mnew; \
                } \
                float ps = 0.f; \
_Pragma("unroll") \
                for (int r = 0; r < 16; ++r) { sx[r] = __builtin_amdgcn_exp2f(sx[r] - mnew); ps += sx[r]; } \
                lsum = lsum * alpha + ps; \
                if (ti < 4 && __builtin_amdgcn_ballot_w64(alpha != 1.0f) != 0ull) { \
_Pragma("unroll") \
                    for (int d = 0; d < 4; ++d) \
_Pragma("unroll") \
                        for (int r = 0; r < 16; ++r) o[d][r] *= alpha; \
                } \
                bf16x8 pk[2]; \
_Pragma("unroll") \
                for (int s2 = 0; s2 < 2; ++s2) { \
                    u32x4 t0; \
_Pragma("unroll") \
                    for (int e = 0; e < 4; ++e) t0[e] = cvt_pk_bf16(sx[8 * s2 + 2 * e], sx[8 * s2 + 2 * e + 1]); \
                    pk[s2] = __builtin_bit_cast(bf16x8, t0); \
                } \
_Pragma("unroll") \
                for (int d = 0; d < 4; ++d) \
_Pragma("unroll") \
                    for (int s2 = 0; s2 < 2; ++s2) { \
                        const LAS unsigned char* vp = vb + (32 * u + 16 * s2) * VSTR + d * 64; \
                        const s16x4 x0 = __builtin_amdgcn_ds_read_tr16_b64_v4i16((LAS s16x4*)vp), x1 = __builtin_amdgcn_ds_read_tr16_b64_v4i16((LAS s16x4*)(vp + 8 * VSTR)); \
                        const bf16x8 av = (bf16x8){x0[0], x0[1], x0[2], x0[3], x1[0], x1[1], x1[2], x1[3]}; \
                        o[d] = __builtin_amdgcn_mfma_f32_32x32x16_bf16(av, pk[s2], o[d], 0, 0, 0); \
                    } \
            } \
        } \
        if (ti + 1 < ntile) ATT_STORE(KX, VX, buf ^ 1); \
        __syncthreads(); \
    } while (0)
    for (int t2 = 0; t2 < ntile; t2 += 2) {
        ATT_TILE(t2, krA, vrA, krB, vrB);
        if (t2 + 1 < ntile) ATT_TILE(t2 + 1, krB, vrB, krA, vrA);
    }
#undef ATT_TILE
#undef ATT_LOAD
#undef ATT_KEY0
#undef ATT_STORE
    lsum += __shfl_xor(lsum, 32);
    const float inv = 1.0f / lsum;
    bf16_t* op = mix + qrow * DM + h * 128 + 4 * hh;
#pragma unroll
    for (int d = 0; d < 4; ++d)
#pragma unroll
        for (int rg = 0; rg < 4; ++rg) {
            u32x2 wv; wv[0] = cvt_pk_bf16(o[d][4 * rg] * inv, o[d][4 * rg + 1] * inv); wv[1] = cvt_pk_bf16(o[d][4 * rg + 2] * inv, o[d][4 * rg + 3] * inv);
            *(u32x2*)(op + 32 * d + 8 * rg) = wv;
        }
}

__device__ __forceinline__ void attn_phase(LAS unsigned char* lds, const unsigned char* ws, unsigned* queue, const int l, const int wv) {
    const bf16_t* Q = (const bf16_t*)(ws + WS_Q); const bf16_t* K = (const bf16_t*)(ws + WS_K); const bf16_t* Vt = (const bf16_t*)(ws + WS_VT);
    const float* kmean = (const float*)(ws + WS_KMEAN) + (size_t)l * 8 * 8 * 8 * 128;
    bf16_t* mix = (bf16_t*)(ws + WS_MIX);
    LAS int* slot = (LAS int*)(lds + L_END);
    for (;;) {
        __syncthreads();
        if (mk_tid(wv) == 0) *slot = (int)atomicAdd(queue, 1u);
        __syncthreads();
        const int u = *slot;
        if (u >= 512) break;
        const int blk = 7 - (u >> 6), bh = u & 63;
        attn_unit(lds, Q, K, Vt, kmean, mix, bh >> 3, bh & 7, blk, wv);
    }
}
__device__ __forceinline__ void attn_cvt_phase(const MkArgs& a, LAS unsigned char* lds, unsigned* aqueue, unsigned* cqueue, const int l, const int clo, const int chi, const int cper, const int wv) {
    const unsigned char* ws = a.ws;
    const bf16_t* Q = (const bf16_t*)(ws + WS_Q); const bf16_t* K = (const bf16_t*)(ws + WS_K); const bf16_t* Vt = (const bf16_t*)(ws + WS_VT);
    const float* kmean = (const float*)(ws + WS_KMEAN) + (size_t)l * 8 * 8 * 8 * 128;
    bf16_t* mix = (bf16_t*)(ws + WS_MIX);
    LAS int* slot = (LAS int*)(lds + L_END);
    bool adone = false, cdone = (clo >= chi);
    int turn = (int)blockIdx.x & 1;
    while (!(adone && cdone)) {
        if (turn == 0) {
            if (!adone) {
                __syncthreads();
                if (mk_tid(wv) == 0) *slot = (int)atomicAdd(aqueue, 1u);
                __syncthreads();
                const int u = *slot;
                if (u >= 512) adone = true;
                else {
                    int blk, bh;
                    if (u < 320) { bh = u / 5; blk = 7 - (u - 5 * bh); } else { const int v = u - 320; blk = 2 - (v >> 6); bh = v & 63; }
                    attn_unit(lds, Q, K, Vt, kmean, mix, bh >> 3, bh & 7, blk, wv); }
            }
        } else if (!cdone) {
            __syncthreads();
            if (mk_tid(wv) == 0) *slot = clo + (int)atomicAdd(cqueue, (unsigned)cper);
            __syncthreads();
            const int base = *slot;
            if (base >= chi) cdone = true;
            else { int tid = mk_tid(wv); asm volatile("" : "+v"(tid)); cvt_range(a, lds, tid, base, 1, (base + cper < chi) ? base + cper : chi, true); }
        }
        turn ^= 1;
    }
}
}

namespace gla {
typedef float f32x16 __attribute__((ext_vector_type(16)));
typedef short s16x4 __attribute__((ext_vector_type(4)));
constexpr int QS = 272, ES = 320, VS = 576, OS = 260;
constexpr int L_Q = 0, L_K = L_Q + 64 * QS, L_OB = 0, L_KE = 64 * OS * 4, L_V = L_KE + 64 * ES, L_FR = L_V + 64 * VS, L_DEC = L_FR + 3 * 2 * 64 * 16, L_GON = L_DEC + 512, L_END = L_GON + 1024;
static_assert(L_K + 64 * QS <= L_KE, "obuf (f32 [64][OS]) covers q~ and k~, which are dead when it is written");
static_assert(L_END <= 160 * 1024 - 64, "LDS budget");

__device__ __forceinline__ bf16x8 ld2x64(const LAS unsigned char* p) {
    const u32x2 lo = *(const LAS u32x2*)p, hi = *(const LAS u32x2*)(p + 16);
    return __builtin_bit_cast(bf16x8, (u32x4){lo[0], lo[1], hi[0], hi[1]});
}
__device__ __forceinline__ bf16x8 tr8(const LAS unsigned char* p0, const LAS unsigned char* p1) {
    const s16x4 a = __builtin_amdgcn_ds_read_tr16_b64_v4i16((LAS s16x4*)p0), b = __builtin_amdgcn_ds_read_tr16_b64_v4i16((LAS s16x4*)p1);
    return (bf16x8){a[0], a[1], a[2], a[3], b[0], b[1], b[2], b[3]};
}
__device__ __forceinline__ bf16x8 pack8(const f32x16& x, const int s2) {
    u32x4 t;
#pragma unroll
    for (int e = 0; e < 4; ++e) t[e] = cvt_pk_bf16(x[8 * s2 + 2 * e], x[8 * s2 + 2 * e + 1]);
    return __builtin_bit_cast(bf16x8, t);
}

__device__ __forceinline__ void gla_unit(LAS unsigned char* lds, const unsigned char* ws, const float* g_onorm, const int b, const int h, const int wv) {
    int tid = mk_tid(wv); asm volatile("" : "+v"(tid));
    const int w = __builtin_amdgcn_readfirstlane(tid >> 6), lane = tid & 63, j = lane & 31, hh = lane >> 5;
    const bf16_t* QG = (const bf16_t*)(ws + WS_QG); const bf16_t* KG = (const bf16_t*)(ws + WS_KG);
    const bf16_t* VG = (const bf16_t*)(ws + WS_VG); const bf16_t* OG = (const bf16_t*)(ws + WS_OG);
    const float* BC = (const float*)(ws + WS_LA); bf16_t* mix = (bf16_t*)(ws + WS_MIX);
    LAS float* dec = (LAS float*)(lds + L_DEC); LAS float* gon = (LAS float*)(lds + L_GON); LAS float* obuf = (LAS float*)(lds + L_OB);
    f32x16 S[4];
#pragma unroll
    for (int et = 0; et < 4; ++et)
#pragma unroll
        for (int r = 0; r < 16; ++r) S[et][r] = 0.f;
    __syncthreads();
    if (tid < 256) gon[tid] = g_onorm[tid];
    u32x4 qr[2][2], kr[2][2], vr[2][4], ogr[4]; f32x4 dr = (f32x4){0.f, 0.f, 0.f, 0.f};
    const unsigned o16 = (unsigned)tid * 16u, oog = (unsigned)tid * 64u;
#define GLA_LOAD(ps, n) do { const size_t _t0 = ((size_t)(b * 4 + h) * SEQ + 64 * (n)); \
        const char* _qb = (const char*)(QG + _t0 * 128); const char* _kb = (const char*)(KG + _t0 * 128); \
        const char* _vb = (const char*)(VG + _t0 * 256); \
        _Pragma("unroll") for (int _i = 0; _i < 2; ++_i) { qr[ps][_i] = *(const u32x4*)(_qb + _i * 8192 + o16); kr[ps][_i] = *(const u32x4*)(_kb + _i * 8192 + o16); } \
        _Pragma("unroll") for (int _i = 0; _i < 4; ++_i) vr[ps][_i] = *(const u32x4*)(_vb + _i * 8192 + o16); \
        } while (0)
#define GLA_LOAD_DR(n) do { if (tid < 32) dr = *(const f32x4*)(BC + ((size_t)b * SEQ + 64 * (n) + 63) * 512 + h * 128 + tid * 4); } while (0)
    const LAS unsigned char* qb8 = lds + L_Q + j * QS + hh * 8;  const LAS unsigned char* qb16 = lds + L_Q + j * QS + hh * 16;
    const LAS unsigned char* kb16 = lds + L_K + j * QS + hh * 16;
    const int li = lane & 15, gq = li >> 2, gp = li & 3, gg = (lane >> 4) & 1;
    const LAS unsigned char* keN = lds + L_KE + (gq + 8 * hh) * ES + (16 * gg + 4 * gp) * 2;
    const LAS unsigned char* vN = lds + L_V + (gq + 8 * hh) * VS + (32 * w + 16 * gg + 4 * gp) * 2;
    const LAS unsigned char* vP = lds + L_V + (gq + 4 * hh) * VS + (32 * w + 16 * gg + 4 * gp) * 2;
    const LAS float* decb = dec + 4 * hh; LAS float* ob = obuf + 4 * hh * OS + 32 * w + j;
    LAS unsigned char* frb = lds + L_FR + lane * 16;
#define GLA_LOAD_OG(ps, n) do { const char* _ob = (const char*)(OG + ((size_t)(b * 4 + h) * SEQ + 64 * (n)) * 256); \
        _Pragma("unroll") for (int x = 0; x < 4; ++x) ogr[x] = *(const u32x4*)(_ob + oog + x * 16); } while (0)
    GLA_LOAD(0, 0); GLA_LOAD_DR(0); GLA_LOAD(1, 1);
    for (int n2 = 0; n2 < SEQ / 64; n2 += 2)
#pragma unroll
    for (int par = 0; par < 2; ++par) {
        const int n = n2 + par;
        const size_t t0 = (size_t)b * SEQ + 64 * n;
        __syncthreads();
#pragma unroll
        for (int i = 0; i < 2; ++i) { const int c = tid + 512 * i, row = c >> 4, cc = (c & 15) * 16;
            *(LAS u32x4*)(lds + L_Q + row * QS + cc) = qr[par][i]; *(LAS u32x4*)(lds + L_K + row * QS + cc) = kr[par][i]; }
#pragma unroll
        for (int i = 0; i < 4; ++i) { const int c = tid + 512 * i; *(LAS u32x4*)(lds + L_V + (c >> 5) * VS + (c & 31) * 16) = vr[par][i]; }
        if (tid < 32) {
            const float L2E_ = 1.4426950408889634f;
            *(LAS f32x4*)&dec[tid * 4] = (f32x4){__builtin_amdgcn_exp2f(dr[0] * L2E_), __builtin_amdgcn_exp2f(dr[1] * L2E_), __builtin_amdgcn_exp2f(dr[2] * L2E_), __builtin_amdgcn_exp2f(dr[3] * L2E_)};
        }
        __syncthreads();
        GLA_LOAD_OG(0, n);
#pragma unroll
        for (int i = 0; i < 2; ++i) {
            const int c = tid + 512 * i, row = c >> 4, kc = (c & 15) * 8;
            const f32x4 d0 = *(const LAS f32x4*)&dec[kc], d1 = *(const LAS f32x4*)&dec[kc + 4];
            const u32x4 kv = kr[par][i]; u32x4 ke;
            ke[0] = cvt_pk_bf16(bf_lo(kv[0]) * d0[0], bf_hi(kv[0]) * d0[1]); ke[1] = cvt_pk_bf16(bf_lo(kv[1]) * d0[2], bf_hi(kv[1]) * d0[3]);
            ke[2] = cvt_pk_bf16(bf_lo(kv[2]) * d1[0], bf_hi(kv[2]) * d1[1]); ke[3] = cvt_pk_bf16(bf_lo(kv[3]) * d1[2], bf_hi(kv[3]) * d1[3]);
            *(LAS u32x4*)(lds + L_KE + row * ES + (c & 15) * 16) = ke;
        }
        if (n + 1 < SEQ / 64) GLA_LOAD_DR(n + 1);
        if (n + 2 < SEQ / 64) GLA_LOAD(par, n + 2);
        if (w < 3) {
            const int st = (w == 2) ? 1 : 0, tt = (w == 0) ? 0 : 1;
            f32x16 X;
#pragma unroll
            for (int r = 0; r < 16; ++r) X[r] = 0.f;
#pragma unroll
            for (int ks = 0; ks < 8; ++ks) {
                const bf16x8 ak = *(const LAS bf16x8*)(kb16 + 32 * st * QS + ks * 32);
                const bf16x8 bq2 = *(const LAS bf16x8*)(qb16 + 32 * tt * QS + ks * 32);
                X = __builtin_amdgcn_mfma_f32_32x32x16_bf16(ak, bq2, X, 0, 0, 0);
            }
            if (st == tt) {
#pragma unroll
                for (int r = 0; r < 16; ++r) { const int sr = (r & 3) + 8 * (r >> 2) + 4 * hh; if (sr > j) X[r] = 0.f; }
            }
            *(LAS bf16x8*)(frb + (w * 2 + 0) * 1024) = pack8(X, 0); *(LAS bf16x8*)(frb + (w * 2 + 1) * 1024) = pack8(X, 1);
        }
        f32x16 O[2];
#pragma unroll
        for (int tt = 0; tt < 2; ++tt)
#pragma unroll
            for (int r = 0; r < 16; ++r) O[tt][r] = 0.f;
#pragma unroll
        for (int et = 0; et < 4; ++et)
#pragma unroll
            for (int s2 = 0; s2 < 2; ++s2) {
                const bf16x8 sb = pack8(S[et], s2);
#pragma unroll
                for (int tt = 0; tt < 2; ++tt) {
                    const bf16x8 aq = ld2x64(qb8 + 32 * tt * QS + (32 * et + 16 * s2) * 2);
                    O[tt] = __builtin_amdgcn_mfma_f32_32x32x16_bf16(aq, sb, O[tt], 0, 0, 0);
                }
            }
        __syncthreads();
#pragma unroll
        for (int pr = 0; pr < 3; ++pr) {
            const int st = (pr == 2) ? 1 : 0, tt = (pr == 0) ? 0 : 1;
#pragma unroll
            for (int s2 = 0; s2 < 2; ++s2) {
                const bf16x8 ax = *(const LAS bf16x8*)(frb + (pr * 2 + s2) * 1024);
                const LAS unsigned char* vp = vP + (32 * st + 16 * s2) * VS;
                const bf16x8 bv = tr8(vp, vp + 8 * VS);
                O[tt] = __builtin_amdgcn_mfma_f32_32x32x16_bf16(ax, bv, O[tt], 0, 0, 0);
            }
        }
        __builtin_amdgcn_sched_barrier(0);
#pragma unroll
        for (int tt = 0; tt < 2; ++tt)
#pragma unroll
            for (int r = 0; r < 16; ++r) ob[(32 * tt + (r & 3) + 8 * (r >> 2)) * OS] = O[tt][r];
        __builtin_amdgcn_sched_barrier(0);
#pragma unroll
        for (int et = 0; et < 4; ++et)
#pragma unroll
            for (int rg = 0; rg < 4; ++rg) { const f32x4 dl = *(const LAS f32x4*)&decb[32 * et + 8 * rg];
#pragma unroll
                for (int x = 0; x < 4; ++x) S[et][4 * rg + x] *= dl[x]; }
#pragma unroll
        for (int ks = 0; ks < 4; ++ks) {
            const LAS unsigned char* vp = vN + 16 * ks * VS;
            const bf16x8 bv = tr8(vp, vp + 4 * VS);
#pragma unroll
            for (int et = 0; et < 4; ++et) {
                const LAS unsigned char* kp = keN + 32 * et * 2 + 16 * ks * ES;
                const bf16x8 ak = tr8(kp, kp + 4 * ES);
                S[et] = __builtin_amdgcn_mfma_f32_32x32x16_bf16(ak, bv, S[et], 0, 0, 0);
            }
        }
        __syncthreads();
        {
            const int t = tid >> 3, g8 = tid & 7;
            float ov[32]; float ss = 0.f;
#pragma unroll
            for (int x = 0; x < 8; ++x) { const f32x4 v = *(const LAS f32x4*)&obuf[t * OS + 32 * g8 + 4 * x]; ov[4 * x] = v[0]; ov[4 * x + 1] = v[1]; ov[4 * x + 2] = v[2]; ov[4 * x + 3] = v[3];
                ss += v[0] * v[0] + v[1] * v[1] + v[2] * v[2] + v[3] * v[3]; }
            ss += __builtin_bit_cast(float, __builtin_amdgcn_ds_swizzle(__builtin_bit_cast(int, ss), (1 << 10) | 0x1F)); ss += __builtin_bit_cast(float, __builtin_amdgcn_ds_swizzle(__builtin_bit_cast(int, ss), (2 << 10) | 0x1F));
            ss += __builtin_bit_cast(float, __builtin_amdgcn_ds_swizzle(__builtin_bit_cast(int, ss), (4 << 10) | 0x1F));
            const float rstd = __builtin_amdgcn_rsqf(ss * (1.0f / 256.0f) + EPSV);
            bf16_t* mp = mix + (t0 + t) * DM + 1024 + h * 256 + 32 * g8;
#pragma unroll
            for (int x = 0; x < 4; ++x) {
                const u32x4 og = ogr[x];
                const f32x4 g0 = *(const LAS f32x4*)&gon[32 * g8 + 8 * x], g1 = *(const LAS f32x4*)&gon[32 * g8 + 8 * x + 4];
                const float gg2[8] = {g0[0], g0[1], g0[2], g0[3], g1[0], g1[1], g1[2], g1[3]};
                float res[8];
#pragma unroll
                for (int y = 0; y < 4; ++y) { const float a0 = bf_lo(og[y]), a1 = bf_hi(og[y]);
                    res[2 * y] = ov[8 * x + 2 * y] * rstd * gg2[2 * y] * a0;
                    res[2 * y + 1] = ov[8 * x + 2 * y + 1] * rstd * gg2[2 * y + 1] * a1; }
                u32x4 wv4; wv4[0] = cvt_pk_bf16(res[0], res[1]); wv4[1] = cvt_pk_bf16(res[2], res[3]); wv4[2] = cvt_pk_bf16(res[4], res[5]); wv4[3] = cvt_pk_bf16(res[6], res[7]);
                *(u32x4*)(mp + 8 * x) = wv4;
            }
        }
    }
#undef GLA_LOAD
#undef GLA_LOAD_OG
#undef GLA_LOAD_DR
}
}

__device__ __forceinline__ int moe_idle_wgs(const int* cnt0, const int G) {
    int tiles = 0;
    for (int e = 0; e < NEXP; ++e) tiles += (cnt0[e] + 255) >> 8;
    const int rem = (tiles * 8) % G;
    return rem ? G - rem : 0;
}
constexpr int DEF_RES13 = 2048;
constexpr int DEF_TPB6 = 0, DEF_TPB7 = 0;
__global__ void __launch_bounds__(512, 2) mk_fwd(MkArgs a) {
    extern __shared__ __attribute__((aligned(16))) unsigned char lds_raw[];
    LAS unsigned char* lds = (LAS unsigned char*)lds_raw;
    volatile LAS unsigned* misc = (volatile LAS unsigned*)(lds + LDS_MISC);
    const int wv = __builtin_amdgcn_readfirstlane((int)threadIdx.x >> 6);
    { const int t0_ = mk_tid(wv); if (t0_ < 4) misc[t0_] = 0u; }
    __syncthreads();
    const int lo = a.ph_lo, hi = a.ph_hi;
    unsigned char* ws = a.ws;
    XcdBarrier bar; bar.bar = (unsigned*)(ws + WS_CTL); bar.x = 0; bar.st = misc; bar.wv = wv;
    if (hi - lo > 1) bar = xcd_barrier_post((unsigned*)(ws + WS_CTL), misc, wv);
#define IN(k) (lo <= (k) && (k) < hi)
#define SEAM(k) do { if (IN(k) && IN((k) + 1)) xcd_barrier(bar); } while (0)
    const int G = gridDim.x;
    const int cid = (int)blockIdx.x;
    if (IN(0)) p0_prologue(a, lds, wv);
    SEAM(0);
#define MK_LAYER(l) do { \
        const int pb = 1 + 7 * l; \
        const float* modl = (const float*)(ws + WS_MOD) + (size_t)l * 8 * 6 * DM; \
        if (IN(pb)) { if (l == 0) norm_phase<0>(a, lds, 0, wv); else norm_phase<1>(a, lds, 1, wv); } \
        SEAM(pb); \
        if (IN(pb + 1)) { \
            pg8::DenseOrder S; S.init(NTOK, 6144, DM, (const bf16_t*)(ws + WS_WIN) + (size_t)l * 6144 * DM, G, cid); \
            pg8::EpiInProj E{ws, (float*)(ws + WS_KMEAN) + (size_t)l * 8 * 8 * 8 * 128, (const float*)(ws + WS_ROPE), (const float*)(ws + WS_LA)}; \
            pg8::gemm_phase(lds, (const bf16_t*)(ws + WS_H), DM, S, E, wv); \
        } \
        SEAM(pb + 1); \
        if (IN(pb + 2)) { \
            if (blockIdx.x < 32) gla::gla_unit(lds, ws, a.in[9] + l * 256, (int)blockIdx.x >> 2, (int)blockIdx.x & 3, wv); \
            { int dlo = 0, dhi = DEF_CAP3; \
              if (l == 1) { const int idle = moe_idle_wgs((const int*)(ws + WS_CNT), G); dlo = DEF_CAP3 + idle * (DEF_TPB6 + DEF_TPB7); dhi = NT_DEF - DEF_RES13; dlo = dlo < dhi ? dlo : dhi; } \
              attn::attn_cvt_phase(a, lds, (unsigned*)(ws + WS_CTL + 20480) + l * 64, (unsigned*)(ws + WS_CTL + 20480) + 128 + l * 64, l, dlo, dhi, l == 0 ? 12 : 20, wv); } \
        } \
        SEAM(pb + 2); \
        if (IN(pb + 3)) { \
            pg8::DenseOrder S; S.init(NTOK, DM, DM, (const bf16_t*)(ws + WS_WOUT) + (size_t)l * DM * DM, G, cid); \
            pg8::EpiResGate E{l == 0 ? a.in[0] : (const float*)(ws + WS_X), (float*)(ws + WS_X), modl + 2 * DM}; \
            pg8::gemm_phase(lds, (const bf16_t*)(ws + WS_MIX), DM, S, E, wv); \
        } \
        SEAM(pb + 3); \
        if (IN(pb + 4)) norm_phase<2>(a, lds, l, wv); \
        SEAM(pb + 4); \
        if (IN(pb + 5)) { \
            LAS int* tb = (LAS int*)(lds + 131072 + 1024); \
            pg8::moe_tiles((const int*)(ws + WS_CNT) + l * NEXP, tb, wv); \
            LAS int* rowtab = (LAS int*)(lds + 131072 + 2048); \
            pg8::MoeOrder S{(const int*)(ws + WS_SLOT), (const bf16_t*)(ws + WS_WGU) + (size_t)l * NEXP * 2048 * DM, DM, G, cid, 1, tb, rowtab}; \
            S.fill_rows(mk_tid(wv)); \
            pg8::EpiMoe1 E{rowtab, (bf16_t*)(ws + WS_ACT)}; \
            pg8::gemm_phase(lds, (const bf16_t*)(ws + WS_H), DM, S, E, wv); \
            if (l == 0) cvt_deferred(a, lds, wv, (unsigned*)(ws + WS_CTL + 20480) + 128 + 5 * 64, NT_DEF, NT_DEF + DEF_RES6); \
            else cvt_deferred(a, lds, wv, (unsigned*)(ws + WS_CTL + 20480) + 128 + 4 * 64, NT_DEF - DEF_RES13, NT_DEF); \
        } \
        SEAM(pb + 5); \
        if (IN(pb + 6)) { \
            LAS int* tb = (LAS int*)(lds + 131072 + 1024); \
            pg8::moe_tiles((const int*)(ws + WS_CNT) + l * NEXP, tb, wv); \
            LAS int* rowtab = (LAS int*)(lds + 131072 + 2048); \
            pg8::MoeOrder S{(const int*)(ws + WS_SLOT), (const bf16_t*)(ws + WS_WD) + (size_t)l * NEXP * DM * DEXP, DEXP, G, cid, 0, tb, rowtab}; \
            S.fill_rows(mk_tid(wv)); \
            pg8::EpiMoe2 E{rowtab, (bf16_t*)(ws + WS_YB)}; \
            pg8::gemm_phase(lds, (const bf16_t*)(ws + WS_ACT), DEXP, S, E, wv); \
            if (l == 0) cvt_deferred(a, lds, wv, (unsigned*)(ws + WS_CTL + 20480) + 128 + 6 * 64, NT_DEF + DEF_RES6, NT_DEF + DEF_RES6 + DEF_RES7); \
        } \
        SEAM(pb + 6); \
    } while (0)
    MK_LAYER(0);
    MK_LAYER(1);
#undef MK_LAYER
    if (IN(15)) norm_phase<3>(a, lds, 1, wv);
#undef IN
#undef SEAM
}

static void mk_launch(const MkArgs& base, int lo, int hi, hipStream_t stream) {
    static bool attr = false;
    if (!attr) { (void)hipFuncSetAttribute((const void*)mk_fwd, hipFuncAttributeMaxDynamicSharedMemorySize, LDS_BYTES); attr = true; }
    MkArgs a = base; a.ph_lo = lo; a.ph_hi = hi;
    hipLaunchKernelGGL(mk_fwd, dim3(256), dim3(512), LDS_BYTES, stream, a);
}

extern "C" void kernel_launch(void* const* d_in, const int* in_sizes, int n_in, void* d_out, int out_size, void* d_ws, size_t ws_size, hipStream_t stream) {
    MkArgs base{};
    for (int i = 0; i < 19; ++i) base.in[i] = (const float*)d_in[i];
    base.out = (float*)d_out; base.ws = (unsigned char*)d_ws;
    (void)hipMemsetAsync((unsigned char*)d_ws + WS_CTL, 0, CTL_BYTES, stream);
    mk_launch(base, 0, NPHASE, stream);
}
```

```cpp
#include <hip/hip_runtime.h>
#include <stdint.h>

#define DM 2048
#define NBATCH 8
#define SEQ 2048
#define NTOK (NBATCH * SEQ)
#define INW 6160
#define OFF_GA 6144
#define NEXP 32
#define DEXP 1024
#define ECAP 16384
#define EPSV 1e-6f


#define LAS __attribute__((address_space(3)))
typedef unsigned short bf16_t;
typedef short bf16x8 __attribute__((ext_vector_type(8)));
typedef float f32x4 __attribute__((ext_vector_type(4)));
typedef unsigned u32x4 __attribute__((ext_vector_type(4)));
typedef unsigned u32x2 __attribute__((ext_vector_type(2)));

#define ATTN_SCALE_F 0.08838834764831845f
#define QSCALE (ATTN_SCALE_F * 1.4426950408889634f)

typedef float f32x2_t __attribute__((ext_vector_type(2)));
typedef __bf16 bf16x2_t __attribute__((ext_vector_type(2)));
__device__ __forceinline__ unsigned cvt_pk_bf16(float lo, float hi) { const bf16x2_t r = __builtin_convertvector((f32x2_t){lo, hi}, bf16x2_t); return __builtin_bit_cast(unsigned, r); }
__device__ __forceinline__ float silu_fast(float x) { return x * __builtin_amdgcn_rcpf(1.0f + __builtin_amdgcn_exp2f(-x * 1.4426950408889634f)); }
__device__ __forceinline__ float bf_lo(unsigned w) { return __uint_as_float(w << 16); }
__device__ __forceinline__ float bf_hi(unsigned w) { return __uint_as_float(w & 0xffff0000u); }

__device__ __forceinline__ int mk_tid(const int wv) { int ln; asm volatile("v_mbcnt_lo_u32_b32 %0, -1, 0\n\tv_mbcnt_hi_u32_b32 %0, -1, %0" : "=v"(ln)); return wv * 64 + ln; }

constexpr size_t AL(size_t x) { return (x + 255) & ~(size_t)255; }
constexpr size_t WS_CTL = 0;
constexpr size_t CTL_BYTES = 32768;
constexpr size_t WS_CNT = WS_CTL + 16384;
constexpr size_t WS_MOD = AL(WS_CTL + CTL_BYTES);
constexpr size_t WS_ROPE = AL(WS_MOD + (size_t)2 * 8 * 6 * DM * 4);
constexpr size_t WS_KMEAN = AL(WS_ROPE + (size_t)SEQ * 32 * 4);
constexpr size_t WS_WIN = AL(WS_KMEAN + (size_t)2 * 8 * 8 * 8 * 128 * 4);
constexpr size_t WS_WOUT = AL(WS_WIN + (size_t)2 * 6144 * DM * 2);
constexpr size_t WS_WGU = AL(WS_WOUT + (size_t)2 * DM * DM * 2);
constexpr size_t WS_WD = AL(WS_WGU + (size_t)2 * NEXP * 2048 * DM * 2);
constexpr size_t WS_X = AL(WS_WD + (size_t)2 * NEXP * DM * DEXP * 2);
constexpr size_t WS_H = AL(WS_X + (size_t)NTOK * DM * 4);
constexpr size_t WS_Q = AL(WS_H + (size_t)NTOK * DM * 2);
constexpr size_t WS_K = AL(WS_Q + (size_t)NTOK * 1024 * 2);
constexpr size_t WS_VT = AL(WS_K + (size_t)NTOK * 1024 * 2);
constexpr size_t WS_QG = AL(WS_VT + (size_t)NTOK * 1024 * 2);
constexpr size_t WS_KG = AL(WS_QG + (size_t)NTOK * 512 * 2);
constexpr size_t WS_VG = AL(WS_KG + (size_t)NTOK * 512 * 2);
constexpr size_t WS_OG = AL(WS_VG + (size_t)NTOK * 1024 * 2);
constexpr size_t WS_LA = AL(WS_OG + (size_t)NTOK * 1024 * 2);
constexpr size_t WS_MIX = AL(WS_LA + (size_t)NTOK * 512 * 4);
constexpr size_t WS_ACT = AL(WS_MIX + (size_t)NTOK * DM * 2);
constexpr size_t WS_YB = AL(WS_ACT + (size_t)2 * NTOK * DEXP * 2);
constexpr size_t WS_SLOT = AL(WS_YB + (size_t)2 * NTOK * DM * 2);
constexpr size_t WS_TOKW = AL(WS_SLOT + (size_t)NEXP * ECAP * 4);
constexpr size_t WS_WRF = AL(WS_TOKW + (size_t)NTOK * 2 * 4);
constexpr size_t WS_WGAF = AL(WS_WRF + (size_t)2 * 64 * 3 * 2 * 64 * 16);
constexpr size_t WS_KE = AL(WS_WGAF + (size_t)2 * 64 * 2 * 64 * 16);
constexpr size_t WS_FAST_END = AL(WS_KE + (size_t)NTOK * 512 * 2);

constexpr int LDS_BYTES = 163840;
constexpr int LDS_MISC = 163840 - 64;
constexpr int NPHASE = 16;

struct MkArgs {
    const float* in[19]; float* out; unsigned char* ws; int ph_lo, ph_hi;
};

#define XB_TMO      128
#define XB_XCNT(j)  (256  + 64 * (j))
#define XB_XSUB(j)  (1280 + 64 * (j))
#define XB_XGEN(j)  (2304 + 64 * (j))
#define XB_TOP      3328
#define XB_TOPGEN   3392
#define XCD_BAR_WORDS 3456
#define XB_SPIN_CAP (1u << 18)
__device__ __forceinline__ unsigned xb_ld(unsigned* p)              { return __hip_atomic_load(p, __ATOMIC_RELAXED, __HIP_MEMORY_SCOPE_AGENT); }
__device__ __forceinline__ unsigned xb_add(unsigned* p, unsigned v) { return __hip_atomic_fetch_add(p, v, __ATOMIC_RELAXED, __HIP_MEMORY_SCOPE_AGENT); }
__device__ __forceinline__ unsigned xb_xcc_id() { return (unsigned)__builtin_amdgcn_s_getreg((3 << 11) | 20) & 0xFu; }
#define XB_SPIN(cond, bar) do { unsigned _sp = 0; while (cond) { __builtin_amdgcn_s_sleep(1); \
    if ((++_sp & 255u) == 0u) { if (xb_ld(&(bar)[XB_TMO])) break; if (_sp > XB_SPIN_CAP) { atomicAdd(&(bar)[XB_TMO], 1u); break; } } } } while (0)
struct XcdBarrier { unsigned* bar; unsigned x; volatile LAS unsigned* st; int wv; };
__device__ __forceinline__ XcdBarrier xcd_barrier_post(unsigned* bar, volatile LAS unsigned* st, const int wv) {
    XcdBarrier b; b.bar = bar; b.x = xb_xcc_id(); b.st = st; b.wv = wv;
    if (mk_tid(wv) == 0) (void)xb_add(&bar[XB_XCNT(b.x)], 1u);
    return b;
}
__device__ __forceinline__ void xcd_barrier_complete(unsigned* bar, unsigned x, unsigned& nloc, unsigned& nx) {
    const unsigned G = gridDim.x * gridDim.y * gridDim.z;
    unsigned sum, cnt, mine, sp = 0u;
    for (;;) {
        sum = 0u; cnt = 0u; mine = 0u;
#pragma unroll
        for (unsigned j = 0; j < 16; ++j) { const unsigned c = xb_ld(&bar[XB_XCNT(j)]); sum += c; cnt += (c > 0u) ? 1u : 0u; mine = (j == x) ? c : mine; }
        if (sum == G) break;
        __builtin_amdgcn_s_sleep(1);
        if ((++sp & 255u) == 0u) { if (xb_ld(&bar[XB_TMO])) break; if (sp > XB_SPIN_CAP) { atomicAdd(&bar[XB_TMO], 1u); break; } }
    }
    nloc = mine > 0u ? mine : 1u; nx = cnt > 0u ? cnt : 1u;
}
__device__ __forceinline__ void xcd_barrier(const XcdBarrier& b) {
    asm volatile("s_waitcnt vmcnt(0)" ::: "memory");
    __syncthreads();
    if (mk_tid(b.wv) == 0) {
        unsigned* bar = b.bar;
        __builtin_amdgcn_s_waitcnt(0);
        unsigned nloc = b.st[0], nx = b.st[1];
        if (nloc == 0u) { xcd_barrier_complete(bar, b.x, nloc, nx); b.st[0] = nloc; b.st[1] = nx; }
        const unsigned old = xb_add(&bar[XB_XSUB(b.x)], 1u);
        const unsigned gen = old / nloc;
        if (old + 1u == (gen + 1u) * nloc) {
            __builtin_amdgcn_fence(__ATOMIC_RELEASE, "agent");
            asm volatile("s_waitcnt vmcnt(0)" ::: "memory");
            const unsigned og = xb_add(&bar[XB_TOP], 1u);
            const unsigned tg = og / nx;
            if (og + 1u == (tg + 1u) * nx) xb_add(&bar[XB_TOPGEN], 1u);
            else XB_SPIN(xb_ld(&bar[XB_TOPGEN]) == tg, bar);
            __builtin_amdgcn_fence(__ATOMIC_ACQUIRE, "agent");
            xb_add(&bar[XB_XGEN(b.x)], 1u);
            asm volatile("s_waitcnt vmcnt(0)" ::: "memory");
        } else {
            XB_SPIN(xb_ld(&bar[XB_XGEN(b.x)]) == gen, bar);
            __builtin_amdgcn_fence(__ATOMIC_ACQUIRE, "agent");
            asm volatile("s_waitcnt vmcnt(0)" ::: "memory");
        }
    }
    __syncthreads();
}

constexpr int NT_IN = 2 * 16 * 48, NT_OUT = 2 * 16 * 16, NT_G = 64 * 16 * 8, NT_D = 64 * 8 * 16;
constexpr int NT_ALL = NT_IN + NT_OUT + 2 * NT_G + NT_D;
__device__ __forceinline__ void cvt_decode(int t, const float* w_in, const float* w_out, const float* w_eg, const float* w_eu, const float* w_ed,
                                           bf16_t* WinT, bf16_t* WoutT, bf16_t* WguT, bf16_t* WdT, const float*& s_, bf16_t*& d_, int& ld_, int& K_) {
    if (t < 2 * NT_G) { const int which = t / NT_G, t3 = t % NT_G, le = t3 / 128, r = t3 % 128, kt = r / 8, nt = r % 8;
        s_ = (which ? w_eu : w_eg) + (size_t)le * DM * DEXP + (size_t)kt * 128 * DEXP + nt * 128; ld_ = DEXP; K_ = DM;
        d_ = WguT + (size_t)le * 2048 * DM + (size_t)(nt * 256 + which * 128) * DM + kt * 128; }
    else if (t < 2 * NT_G + NT_D) { const int t2 = t - 2 * NT_G, le = t2 / 128, r = t2 % 128, kt = r / 16, nt = r % 16;
        s_ = w_ed + (size_t)le * DEXP * DM + (size_t)kt * 128 * DM + nt * 128; ld_ = DM; K_ = DEXP; d_ = WdT + (size_t)le * DM * DEXP + (size_t)nt * 128 * DEXP + kt * 128; }
    else if (t < 2 * NT_G + NT_D + NT_OUT) { const int t2 = t - 2 * NT_G - NT_D, l = 1 - t2 / 256, r = t2 % 256, kt = r / 16, nt = r % 16;
        s_ = w_out + (size_t)l * DM * DM + (size_t)kt * 128 * DM + nt * 128; ld_ = DM; K_ = DM; d_ = WoutT + (size_t)l * DM * DM + (size_t)nt * 128 * DM + kt * 128; }
    else { const int t2 = t - 2 * NT_G - NT_D - NT_OUT, l = 1 - t2 / (16 * 48), r = t2 % (16 * 48), kt = r / 48, nt = r % 48;
        s_ = w_in + (size_t)l * DM * INW + (size_t)kt * 128 * INW + nt * 128; ld_ = INW; K_ = DM; d_ = WinT + (size_t)l * 6144 * DM + (size_t)nt * 128 * DM + kt * 128; }
}
constexpr int DEF_RES6 = 2048;
constexpr int DEF_RES7 = 768 + 256;
constexpr int NT_PRO = 3 * 4096 - DEF_RES6 + 256 + 768, NT_DEF = 3 * 4096, DEF_CAP3 = 4864;
__device__ __forceinline__ int cvt_map(int i, bool deferred) {
    if (deferred) {
        if (i >= NT_DEF) { const int j = i - NT_DEF; if (j < DEF_RES6) return 16384 + 4096 - DEF_RES6 + j;
            const int r = j - DEF_RES6; return r < 768 ? 24576 + 512 + r : 24576 + (r - 768); }
        return i < 4096 ? 4096 + i : (i < 8192 ? i + 8192 : i + 12288); }
    if (i < 12288 - DEF_RES6) return i < 4096 ? i : (i < 8192 ? i + 4096 : i + 8192);
    const int k = i - (12288 - DEF_RES6);
    return k < 256 ? 24576 + 256 + k : 24576 + 1280 + (k - 256);
}
__device__ __forceinline__ void cvt_range(const MkArgs& a, LAS unsigned char* lds, const int tid, const int first, const int step, const int end, const bool deferred) {
    unsigned char* ws = a.ws;
    constexpr int RS = 320;
    const float* w_in = a.in[6]; const float* w_out = a.in[10]; const float* w_eg = a.in[15]; const float* w_eu = a.in[16]; const float* w_ed = a.in[17];
    bf16_t* WinT = (bf16_t*)(ws + WS_WIN); bf16_t* WoutT = (bf16_t*)(ws + WS_WOUT); bf16_t* WguT = (bf16_t*)(ws + WS_WGU); bf16_t* WdT = (bf16_t*)(ws + WS_WD);
    const int kk = tid >> 5, c4 = tid & 31;
    f32x4 v[8], vn[8], vm[8];
    const float* src = nullptr; bf16_t* dst = nullptr; int ld = 0, K = 0;
    const float* srcn = nullptr; bf16_t* dstn = nullptr; int ldn = 0, Kn = 0;
    int t = first;
    if (t < end) { cvt_decode(cvt_map(t, deferred), w_in, w_out, w_eg, w_eu, w_ed, WinT, WoutT, WguT, WdT, src, dst, ld, K);
#pragma unroll
        for (int i = 0; i < 8; ++i) v[i] = __builtin_nontemporal_load((const f32x4*)(src + (size_t)(kk + 16 * i) * ld + c4 * 4)); }
    if (t + step < end) { cvt_decode(cvt_map(t + step, deferred), w_in, w_out, w_eg, w_eu, w_ed, WinT, WoutT, WguT, WdT, srcn, dstn, ldn, Kn);
#pragma unroll
        for (int i = 0; i < 8; ++i) vn[i] = __builtin_nontemporal_load((const f32x4*)(srcn + (size_t)(kk + 16 * i) * ldn + c4 * 4)); }
    while (t < end) {
        const int tm = t + 2 * step; const float* srcm = nullptr; bf16_t* dstm = nullptr; int ldm = 0, Km = 0;
        if (tm < end) { cvt_decode(cvt_map(tm, deferred), w_in, w_out, w_eg, w_eu, w_ed, WinT, WoutT, WguT, WdT, srcm, dstm, ldm, Km);
#pragma unroll
            for (int i = 0; i < 8; ++i) vm[i] = __builtin_nontemporal_load((const f32x4*)(srcm + (size_t)(kk + 16 * i) * ldm + c4 * 4)); }
#pragma unroll
        for (int i = 0; i < 8; ++i) {
            u32x2 p; p[0] = cvt_pk_bf16(v[i][0], v[i][1]); p[1] = cvt_pk_bf16(v[i][2], v[i][3]);
            *(LAS u32x2*)(lds + (kk + 16 * i) * RS + c4 * 8) = p;
        }
        __syncthreads();
        {
            typedef short s16x4_t __attribute__((ext_vector_type(4)));
            const int ln = tid & 63, wq = tid >> 6, li = ln & 15, gq = li >> 2, gp = li & 3, G4 = ln >> 4;
#pragma unroll
            for (int i = 0; i < 4; ++i) {
                const int nb = wq, k8 = 2 * (G4 + 4 * (i >> 1)) + (i & 1);
                const LAS unsigned char* p0 = lds + (8 * k8 + gq) * RS + (16 * nb + 4 * gp) * 2;
                const s16x4_t x0 = __builtin_amdgcn_ds_read_tr16_b64_v4i16((LAS s16x4_t*)p0), x1 = __builtin_amdgcn_ds_read_tr16_b64_v4i16((LAS s16x4_t*)(p0 + 4 * RS));
                typedef short s16x8_t __attribute__((ext_vector_type(8)));
                const s16x8_t o8 = (s16x8_t){x0[0], x0[1], x0[2], x0[3], x1[0], x1[1], x1[2], x1[3]};
                *(u32x4*)(dst + (size_t)(16 * nb + li) * K + k8 * 8) = __builtin_bit_cast(u32x4, o8);
            }
        }
        __syncthreads();
        t += step; src = srcn; dst = dstn; ld = ldn; K = Kn; srcn = srcm; dstn = dstm; ldn = ldm; Kn = Km;
#pragma unroll
        for (int i = 0; i < 8; ++i) { v[i] = vn[i]; vn[i] = vm[i]; }
    }
}
__device__ __forceinline__ void cvt_deferred(const MkArgs& a, LAS unsigned char* lds, const int wv, unsigned* queue, const int lo, const int hi) {
    int tid = mk_tid(wv); asm volatile("" : "+v"(tid));
    LAS int* slot = (LAS int*)(lds + 49152);
    for (;;) {
        __syncthreads();
        if (tid == 0) *slot = lo + (int)atomicAdd(queue, 4u);
        __syncthreads();
        const int base = *slot;
        if (base >= hi) break;
        cvt_range(a, lds, tid, base, 1, (base + 4 < hi) ? base + 4 : hi, true);
    }
}
__device__ __forceinline__ void p0_prologue(const MkArgs& a, LAS unsigned char* lds, const int wv) {
    int tid = mk_tid(wv); asm volatile("" : "+v"(tid));
    const int G = gridDim.x, bx = blockIdx.x;
    unsigned char* ws = a.ws;
    {
        float* rope = (float*)(ws + WS_ROPE);
        for (int idx = bx * 512 + tid; idx < SEQ * 16; idx += G * 512) {
            const int pos = idx >> 4, i = idx & 15;
            const float inv = powf(500000.0f, -(float)i * (2.0f / 32.0f));
            const float ang = (float)pos * inv;
            rope[pos * 32 + i] = cosf(ang); rope[pos * 32 + 16 + i] = sinf(ang);
        }
        float* km = (float*)(ws + WS_KMEAN);
        for (int idx = bx * 512 + tid; idx < 2 * 8 * 8 * 8 * 128; idx += G * 512) km[idx] = 0.f;
    }
    {
        u32x4* wrf = (u32x4*)(ws + WS_WRF); u32x4* wgaf = (u32x4*)(ws + WS_WGAF);
        for (int idx = bx * 512 + tid; idx < 2 * 64 * 4 * 64; idx += G * 512) {
            const int ln = idx & 63, nt = (idx >> 6) & 3, ks = (idx >> 8) & 63, l = idx >> 14;
            const int n = 16 * nt + (ln & 15), k0 = 32 * ks + 8 * (ln >> 4);
            float v[8];
#pragma unroll
            for (int j = 0; j < 8; ++j) {
                const int k = k0 + j;
                if (nt == 3) v[j] = a.in[6][((size_t)l * DM + k) * INW + OFF_GA + (ln & 15)];
                else v[j] = n < 4 ? a.in[11][((size_t)l * DM + k) * 4 + n] : (n < 36 ? a.in[13][((size_t)l * DM + k) * 32 + n - 4] : 0.f);
            }
            u32x4 hi, lo;
#pragma unroll
            for (int e = 0; e < 4; ++e) { const unsigned hp = cvt_pk_bf16(v[2 * e], v[2 * e + 1]); hi[e] = hp; lo[e] = cvt_pk_bf16(v[2 * e] - bf_lo(hp), v[2 * e + 1] - bf_hi(hp)); }
            if (nt == 3) { wgaf[(((size_t)l * 64 + ks) * 2 + 0) * 64 + ln] = hi; wgaf[(((size_t)l * 64 + ks) * 2 + 1) * 64 + ln] = lo; }
            else { wrf[((((size_t)l * 64 + ks) * 3 + nt) * 2 + 0) * 64 + ln] = hi; wrf[((((size_t)l * 64 + ks) * 3 + nt) * 2 + 1) * 64 + ln] = lo; }
        }
    }
    {
        LAS float* cact = (LAS float*)lds;
        LAS float* red = (LAS float*)(lds + 65536);
        const float* c = a.in[1]; const float* w_ada = a.in[4]; const float* b_ada = a.in[5];
        float* mod = (float*)(ws + WS_MOD);
        for (int i = tid; i < NBATCH * DM; i += 512) { const float v = c[i]; cact[i] = v / (1.0f + expf(-v)); }
        __syncthreads();
        for (int cb = bx; cb < 256; cb += G) {
            const int l = cb >> 7, j0 = (cb & 127) * 96;
            if (tid < 384) {
                const int cg = tid % 24, ks = tid / 24;
                f32x4 acc[8];
#pragma unroll
                for (int b = 0; b < 8; ++b) acc[b] = (f32x4){0.f, 0.f, 0.f, 0.f};
                const float* wp = w_ada + ((size_t)l * DM + ks * 128) * (6 * DM) + j0 + cg * 4;
#pragma unroll 8
                for (int k = 0; k < 128; ++k) {
                    const f32x4 w = *(const f32x4*)(wp + (size_t)k * (6 * DM));
#pragma unroll
                    for (int b = 0; b < 8; ++b) acc[b] += cact[b * DM + ks * 128 + k] * w;
                }
#pragma unroll
                for (int b = 0; b < 8; ++b) *(LAS f32x4*)&red[(ks * 8 + b) * 96 + cg * 4] = acc[b];
            }
            __syncthreads();
            for (int o = tid; o < 768; o += 512) {
                const int b = o / 96, j = o % 96; float s = 0.f;
#pragma unroll
                for (int ks = 0; ks < 16; ++ks) s += red[(ks * 8 + b) * 96 + j];
                mod[((size_t)l * 8 + b) * (6 * DM) + j0 + j] = s + b_ada[l * 6 * DM + j0 + j];
            }
            __syncthreads();
        }
    }
    cvt_range(a, lds, tid, bx, G, NT_PRO, false);
}

template <int MODE>
__device__ __forceinline__ void norm_phase(const MkArgs& a, LAS unsigned char* lds, const int l, const int wv) {
    int tid = mk_tid(wv); asm volatile("" : "+v"(tid));
    const int G = gridDim.x, bx = blockIdx.x;
    const int w = __builtin_amdgcn_readfirstlane(tid >> 6), lane = tid & 63, r = lane & 15, q = lane >> 4;
    unsigned char* ws = a.ws;
    float* xcur = (float*)(ws + WS_X);
    bf16_t* hb = (bf16_t*)(ws + WS_H);
    const float* mod = (const float*)(ws + WS_MOD);
    LAS float* ssp = (LAS float*)lds;
    LAS float* part = (LAS float*)(lds + 1024);
    LAS float* lgt = (LAS float*)(lds + 1024 + 8 * 16 * 48 * 4);
    LAS int* rexp = (LAS int*)(lds + 28672);
    LAS int* lcnt = (LAS int*)(lds + 28672 + 512);
    LAS int* lbase = (LAS int*)(lds + 28672 + 640);
    LAS float* tabA = (LAS float*)(lds + 73728);
    LAS float* tabB = (LAS float*)(lds + 81920);
    LAS float* tabG = (LAS float*)(lds + 90112);
    if (MODE == 2 && tid < 32) lcnt[tid] = 0;
    const float* gain = (MODE == 3) ? a.in[18] : (MODE == 2 ? a.in[3] + l * DM : a.in[2] + l * DM);
    float carry = 0.f;
    for (int cb4 = bx * 4; cb4 < NTOK / 16; cb4 += G * 4)
    for (int rb = cb4; rb < cb4 + 4; ++rb) {
        const int t = rb * 16 + r, b = (rb * 16) / SEQ;
        const float* xsrc = (MODE == 0) ? a.in[0] : xcur;
        if (rb == cb4) {
            const int k4 = tid * 4;
            const f32x4 g4 = *(const f32x4*)(gain + k4);
            if constexpr (MODE != 3) {
                const float* sh_ = mod + ((size_t)l * 8 + b) * (6 * DM) + (MODE == 2 ? 3 * DM : 0);
                const f32x4 s4 = *(const f32x4*)(sh_ + k4), c4 = *(const f32x4*)(sh_ + DM + k4);
                *(LAS f32x4*)&tabA[k4] = (f32x4){g4[0] * (1.0f + c4[0]), g4[1] * (1.0f + c4[1]), g4[2] * (1.0f + c4[2]), g4[3] * (1.0f + c4[3])};
                *(LAS f32x4*)&tabB[k4] = s4;
            } else *(LAS f32x4*)&tabA[k4] = g4;
            if constexpr (MODE == 1 || MODE == 3) {
                const int lm_ = (MODE == 1) ? l - 1 : 1;
                *(LAS f32x4*)&tabG[k4] = *(const f32x4*)(mod + ((size_t)lm_ * 8 + b) * (6 * DM) + 5 * DM + k4);
            }
            __syncthreads();
        }
        float xv[64];
#pragma unroll
        for (int j = 0; j < 8; ++j) {
            const int k = 256 * w + 32 * j + 8 * q;
            const f32x4 v0 = *(const f32x4*)(xsrc + (size_t)t * DM + k), v1 = *(const f32x4*)(xsrc + (size_t)t * DM + k + 4);
            xv[8 * j + 0] = v0[0]; xv[8 * j + 1] = v0[1]; xv[8 * j + 2] = v0[2]; xv[8 * j + 3] = v0[3];
            xv[8 * j + 4] = v1[0]; xv[8 * j + 5] = v1[1]; xv[8 * j + 6] = v1[2]; xv[8 * j + 7] = v1[3];
        }
        if constexpr (MODE == 1 || MODE == 3) {
            const float* tokw = (const float*)(ws + WS_TOKW);
            const bf16_t* yb = (const bf16_t*)(ws + WS_YB);
            const float w0 = tokw[2 * t], w1 = tokw[2 * t + 1];
#pragma unroll
            for (int j = 0; j < 8; ++j) {
                const int k = 256 * w + 32 * j + 8 * q;
                const u32x4 y0 = *(const u32x4*)(yb + (size_t)(2 * t) * DM + k), y1 = *(const u32x4*)(yb + (size_t)(2 * t + 1) * DM + k);
                const f32x4 g0 = *(const LAS f32x4*)&tabG[k], g1 = *(const LAS f32x4*)&tabG[k + 4];
                xv[8 * j + 0] += g0[0] * (w0 * bf_lo(y0[0]) + w1 * bf_lo(y1[0])); xv[8 * j + 1] += g0[1] * (w0 * bf_hi(y0[0]) + w1 * bf_hi(y1[0]));
                xv[8 * j + 2] += g0[2] * (w0 * bf_lo(y0[1]) + w1 * bf_lo(y1[1])); xv[8 * j + 3] += g0[3] * (w0 * bf_hi(y0[1]) + w1 * bf_hi(y1[1]));
                xv[8 * j + 4] += g1[0] * (w0 * bf_lo(y0[2]) + w1 * bf_lo(y1[2])); xv[8 * j + 5] += g1[1] * (w0 * bf_hi(y0[2]) + w1 * bf_hi(y1[2]));
                xv[8 * j + 6] += g1[2] * (w0 * bf_lo(y0[3]) + w1 * bf_lo(y1[3])); xv[8 * j + 7] += g1[3] * (w0 * bf_hi(y0[3]) + w1 * bf_hi(y1[3]));
                if constexpr (MODE == 1) {
                    *(f32x4*)(xcur + (size_t)t * DM + k) = (f32x4){xv[8 * j + 0], xv[8 * j + 1], xv[8 * j + 2], xv[8 * j + 3]};
                    *(f32x4*)(xcur + (size_t)t * DM + k + 4) = (f32x4){xv[8 * j + 4], xv[8 * j + 5], xv[8 * j + 6], xv[8 * j + 7]};
                }
            }
        }
        float ss = 0.f;
#pragma unroll
        for (int i = 0; i < 64; ++i) ss += xv[i] * xv[i];
        ss += __shfl_xor(ss, 16); ss += __shfl_xor(ss, 32);
        if (q == 0) ssp[w * 16 + r] = ss;
        __syncthreads();
        float tot = 0.f;
#pragma unroll
        for (int i = 0; i < 8; ++i) tot += ssp[i * 16 + r];
        const float rstd = 1.0f / sqrtf(tot * (1.0f / DM) + EPSV);
#pragma unroll
        for (int j = 0; j < 8; ++j) {
            const int k = 256 * w + 32 * j + 8 * q;
            const f32x4 g0 = *(const LAS f32x4*)&tabA[k], g1 = *(const LAS f32x4*)&tabA[k + 4];
            float gg[8] = {g0[0], g0[1], g0[2], g0[3], g1[0], g1[1], g1[2], g1[3]};
            if constexpr (MODE != 3) {
                const f32x4 s0 = *(const LAS f32x4*)&tabB[k], s1 = *(const LAS f32x4*)&tabB[k + 4];
                const float sv[8] = {s0[0], s0[1], s0[2], s0[3], s1[0], s1[1], s1[2], s1[3]};
#pragma unroll
                for (int i = 0; i < 8; ++i) xv[8 * j + i] = (xv[8 * j + i] * rstd) * gg[i] + sv[i];
                u32x4 o; o[0] = cvt_pk_bf16(xv[8 * j + 0], xv[8 * j + 1]); o[1] = cvt_pk_bf16(xv[8 * j + 2], xv[8 * j + 3]);
                o[2] = cvt_pk_bf16(xv[8 * j + 4], xv[8 * j + 5]); o[3] = cvt_pk_bf16(xv[8 * j + 6], xv[8 * j + 7]);
                *(u32x4*)(hb + (size_t)t * DM + k) = o;
            } else {
#pragma unroll
                for (int i = 0; i < 8; ++i) xv[8 * j + i] = xv[8 * j + i] * rstd * gg[i];
                *(f32x4*)(a.out + (size_t)t * DM + k) = (f32x4){xv[8 * j + 0], xv[8 * j + 1], xv[8 * j + 2], xv[8 * j + 3]};
                *(f32x4*)(a.out + (size_t)t * DM + k + 4) = (f32x4){xv[8 * j + 4], xv[8 * j + 5], xv[8 * j + 6], xv[8 * j + 7]};
            }
        }
        if constexpr (MODE == 0 || MODE == 1) {
            const char* wb = (const char*)(ws + WS_WGAF) + ((size_t)l * 64 + w * 8) * 2 * 1024;
            unsigned lo16 = (unsigned)lane * 16u; asm volatile("" : "+v"(lo16));
#define WFRAG(i) (*(const u32x4*)(wb + (i) * 1024 + lo16))
            f32x4 acc = (f32x4){0.f, 0.f, 0.f, 0.f};
            u32x4 fr[16];
#pragma unroll
            for (int i = 0; i < 16; ++i) fr[i] = WFRAG(i);
#pragma unroll
            for (int j = 0; j < 8; ++j) {
                u32x4 ah, al;
#pragma unroll
                for (int e = 0; e < 4; ++e) { const unsigned hp = cvt_pk_bf16(xv[8 * j + 2 * e], xv[8 * j + 2 * e + 1]); ah[e] = hp;
                    al[e] = cvt_pk_bf16(xv[8 * j + 2 * e] - bf_lo(hp), xv[8 * j + 2 * e + 1] - bf_hi(hp)); }
                const u32x4 bh = fr[2 * j], bl = fr[2 * j + 1];
                acc = __builtin_amdgcn_mfma_f32_16x16x32_bf16(__builtin_bit_cast(bf16x8, ah), __builtin_bit_cast(bf16x8, bh), acc, 0, 0, 0);
                acc = __builtin_amdgcn_mfma_f32_16x16x32_bf16(__builtin_bit_cast(bf16x8, ah), __builtin_bit_cast(bf16x8, bl), acc, 0, 0, 0);
                acc = __builtin_amdgcn_mfma_f32_16x16x32_bf16(__builtin_bit_cast(bf16x8, al), __builtin_bit_cast(bf16x8, bh), acc, 0, 0, 0);
            }
#pragma unroll
            for (int e = 0; e < 4; ++e) part[(w * 16 + 4 * q + e) * 48 + r] = acc[e];
#undef WFRAG
            __syncthreads();
            {
                const float* w_gk = a.in[7] + (size_t)l * 16 * 512; const float* b_gk = a.in[8] + l * 512;
                float wr[16];
#pragma unroll
                for (int c = 0; c < 16; ++c) wr[c] = w_gk[c * 512 + tid];
                const float bz = b_gk[tid];
                LAS float* gs = (LAS float*)(lds + 32768);
                if (tid < 256) {
                    const int rr = tid >> 4, c = tid & 15; float s = 0.f;
#pragma unroll
                    for (int i = 0; i < 8; ++i) s += part[(i * 16 + rr) * 48 + c];
                    gs[tid] = s;
                }
                __syncthreads();
                float* bc = (float*)(ws + WS_LA);
                if ((rb & 3) == 0) carry = 0.f;
#pragma unroll
                for (int rr = 0; rr < 16; ++rr) {
                    const f32x4 g0 = *(const LAS f32x4*)&gs[rr * 16], g1 = *(const LAS f32x4*)&gs[rr * 16 + 4], g2 = *(const LAS f32x4*)&gs[rr * 16 + 8], g3 = *(const LAS f32x4*)&gs[rr * 16 + 12];
                    float z = bz;
#pragma unroll
                    for (int c = 0; c < 4; ++c) z += g0[c] * wr[c] + g1[c] * wr[4 + c] + g2[c] * wr[8 + c] + g3[c] * wr[12 + c];
                    const float ls = fminf(z, 0.f) - 0.6931471805599453f * __builtin_amdgcn_logf(1.0f + __builtin_amdgcn_exp2f(-fabsf(z) * 1.4426950408889634f));
                    carry += ls * (1.0f / 16.0f);
                    bc[(size_t)(rb * 16 + rr) * 512 + tid] = carry;
                }
            }
        }
        if constexpr (MODE == 2) {
            const char* wb = (const char*)(ws + WS_WRF) + ((size_t)l * 64 + w * 8) * 6 * 1024;
            unsigned lo16 = (unsigned)lane * 16u; asm volatile("" : "+v"(lo16));
#define WFRAG(i) (*(const u32x4*)(wb + (i) * 1024 + lo16))
            f32x4 acc[3];
#pragma unroll
            for (int nt = 0; nt < 3; ++nt) acc[nt] = (f32x4){0.f, 0.f, 0.f, 0.f};
            u32x4 frA[16], frB[16];
#define RT_LOAD(fr, c) do { _Pragma("unroll") for (int i = 0; i < 16; ++i) fr[i] = WFRAG((c) * 16 + i); } while (0)
#define RT_MMA(fr, c) do { _Pragma("unroll") for (int s = 0; s < 8; ++s) { \
                    const int st = (c) * 8 + s, j = st / 3, nt = st % 3; \
                    u32x4 ah, al; \
                    _Pragma("unroll") for (int e = 0; e < 4; ++e) { const unsigned hp = cvt_pk_bf16(xv[8 * j + 2 * e], xv[8 * j + 2 * e + 1]); ah[e] = hp; \
                        al[e] = cvt_pk_bf16(xv[8 * j + 2 * e] - bf_lo(hp), xv[8 * j + 2 * e + 1] - bf_hi(hp)); } \
                    const u32x4 bh = fr[2 * s], bl = fr[2 * s + 1]; \
                    acc[nt] = __builtin_amdgcn_mfma_f32_16x16x32_bf16(__builtin_bit_cast(bf16x8, ah), __builtin_bit_cast(bf16x8, bh), acc[nt], 0, 0, 0); \
                    acc[nt] = __builtin_amdgcn_mfma_f32_16x16x32_bf16(__builtin_bit_cast(bf16x8, ah), __builtin_bit_cast(bf16x8, bl), acc[nt], 0, 0, 0); \
                    acc[nt] = __builtin_amdgcn_mfma_f32_16x16x32_bf16(__builtin_bit_cast(bf16x8, al), __builtin_bit_cast(bf16x8, bh), acc[nt], 0, 0, 0); } } while (0)
            RT_LOAD(frA, 0); RT_LOAD(frB, 1);
            RT_MMA(frA, 0);
            RT_LOAD(frA, 2);
            RT_MMA(frB, 1);
            RT_MMA(frA, 2);
#undef RT_LOAD
#undef RT_MMA
#pragma unroll
            for (int nt = 0; nt < 3; ++nt)
#pragma unroll
                for (int e = 0; e < 4; ++e) part[(w * 16 + 4 * q + e) * 48 + 16 * nt + r] = acc[nt][e];
#undef WFRAG
            __syncthreads();
            for (int o = tid; o < 16 * 36; o += 512) {
                const int rr = o / 36, c = o % 36; float s = 0.f;
#pragma unroll
                for (int i = 0; i < 8; ++i) s += part[(i * 16 + rr) * 48 + c];
                lgt[o] = s + (c < 4 ? a.in[12][l * 4 + c] : a.in[14][l * 32 + c - 4]);
            }
            __syncthreads();
            if (tid < 16) {
                const LAS float* sl = lgt + tid * 36; const int tt = rb * 16 + tid;
                int grp = 0; float m = sl[0];
                for (int g = 1; g < 4; ++g) if (sl[g] > m) { m = sl[g]; grp = g; }
                float se = 0.f;
                for (int g = 0; g < 4; ++g) se += __builtin_amdgcn_exp2f((sl[g] - m) * 1.4426950408889634f);
                const float pg = 1.0f / se;
                const LAS float* lgp = sl + 4 + grp * 8;
                const f32x4 l0 = *(const LAS f32x4*)lgp, l1 = *(const LAS f32x4*)(lgp + 4);
                const float lv[8] = {l0[0], l0[1], l0[2], l0[3], l1[0], l1[1], l1[2], l1[3]};
                int i0 = 0; float v0 = lv[0];
#pragma unroll
                for (int jx = 1; jx < 8; ++jx) if (lv[jx] > v0) { v0 = lv[jx]; i0 = jx; }
                int i1 = -1; float v1 = 0.f;
#pragma unroll
                for (int jx = 0; jx < 8; ++jx) if (jx != i0 && (i1 < 0 || lv[jx] > v1)) { v1 = lv[jx]; i1 = jx; }
                const float e1 = __builtin_amdgcn_exp2f((v1 - v0) * 1.4426950408889634f);
                const float p0 = 1.0f / (1.0f + e1), p1 = e1 / (1.0f + e1);
                float* tokw = (float*)(ws + WS_TOKW);
                tokw[2 * tt] = pg * p0; tokw[2 * tt + 1] = pg * p1;
                const int ai = ((rb & 3) * 16 + tid) * 2;
                rexp[ai] = grp * 8 + i0; rexp[ai + 1] = grp * 8 + i1;
            }
            if ((rb & 3) == 3) {
                __syncthreads();
                int e = 0, rk = 0;
                if (tid < 128) { e = rexp[tid]; rk = __hip_atomic_fetch_add(&lcnt[e], 1, __ATOMIC_RELAXED, __HIP_MEMORY_SCOPE_WORKGROUP); }
                __syncthreads();
                if (tid < 32) { const int c = lcnt[tid]; int bs = 0; if (c > 0) bs = atomicAdd((int*)(ws + WS_CNT) + l * NEXP + tid, c); lbase[tid] = bs; lcnt[tid] = 0; }
                __syncthreads();
                if (tid < 128) { int* slot = (int*)(ws + WS_SLOT); slot[(size_t)e * ECAP + lbase[e] + rk] = 2 * ((rb & ~3) * 16 + (tid >> 1)) + (tid & 1); }
            }
        }
        __syncthreads();
    }
}

namespace pg8 {
constexpr int BM = 256, BK = 64, HALF = 128, HTB = HALF * BK * 2, STAGE_BYTES = 8 * HTB, NXCD = 8, WGM = 8;
__device__ __forceinline__ int lds_byte(int r, int c) { const int st = (r >> 4) * 2 + (c >> 5), rr = r & 15, cc = c & 31, ob = rr * 64 + cc * 2; return st * 1024 + (ob ^ (((ob >> 9) & 1) << 5)); }
__device__ __forceinline__ void stage_rc(int b, int& R, int& C) { const int st = b / 1024, sb = b % 1024, swz = sb ^ (((sb >> 9) & 1) << 5); R = (st >> 1) * 16 + swz / 64; C = (st & 1) * 32 + (swz % 64) / 2; }
__device__ __forceinline__ int perm32(int rho) { const int n = rho >> 4, i = rho & 15; return 8 * (i >> 2) + 4 * n + (i & 3); }
struct Unit { int pm, pn, e, rows, ui; };

struct DenseOrder {
    static constexpr bool GATHER = false;
    int nM, nN, nwg, G, c; const bf16_t* Bt; int K;
    __device__ __forceinline__ void init(int M, int N, int K_, const bf16_t* Bt_, int G_, int c_) { nM = M / BM; nN = N / BM; nwg = nM * nN; G = G_; c = c_; Bt = Bt_; K = K_; }
    __device__ __forceinline__ bool next(int i, Unit& u) const {
        const long L = (long)i * G + c; if (L >= nwg) return false;
        int wgid = (int)L; { const int q = nwg / NXCD, r = nwg % NXCD, xcd = wgid % NXCD, off = wgid / NXCD; wgid = (xcd < r ? xcd * (q + 1) : r * (q + 1) + (xcd - r) * q) + off; }
        const int nig = WGM * nN, gid = wgid / nig, fm = gid * WGM, gsz = (nM - fm) < WGM ? (nM - fm) : WGM;
        u.pm = fm + ((wgid % nig) % gsz); u.pn = (wgid % nig) / gsz; u.e = 0; u.rows = 256; u.ui = i; return true;
    }
    __device__ __forceinline__ const char* bptr(const Unit& u) const { return (const char*)Bt + (size_t)u.pn * 256 * K * 2; }
    __device__ __forceinline__ unsigned arow(const Unit& u, int r) const { return (unsigned)(u.pm * 256 + r); }
};

#define PG8_SA(b, h) (((b) * 2 + (h)) * HTB)
#define PG8_SB(b, h) ((4 + (b) * 2 + (h)) * HTB)
#define PG8_STAGE(bufoff, gbase, voff) do { _Pragma("unroll") for (int _i = 0; _i < 2; ++_i) \
        __builtin_amdgcn_global_load_lds((const unsigned*)((const char*)(gbase) + (voff)[_i]), (LAS unsigned*)(lds + (bufoff) + ldsw + _i * 8192), 16, 0, 0); } while (0)
#define PG8_LDA(dst, b, h) do { _Pragma("unroll") for (int m = 0; m < 4; ++m) _Pragma("unroll") for (int k = 0; k < 2; ++k) dst[m][k] = *(const LAS bf16x8*)(lds + PG8_SA(b, h) + aoff + m * 2048 + k * 1024); } while (0)
#define PG8_LDB(dst, b, h) do { _Pragma("unroll") for (int n = 0; n < 2; ++n) _Pragma("unroll") for (int k = 0; k < 2; ++k) dst[n][k] = *(const LAS bf16x8*)(lds + PG8_SB(b, h) + boff + n * 2048 + k * 1024); } while (0)
#define PG8_MMA(ai, bj, At, Bt) do { __builtin_amdgcn_s_setprio(1); _Pragma("unroll") for (int m = 0; m < 4; ++m) _Pragma("unroll") for (int n = 0; n < 2; ++n) _Pragma("unroll") for (int k = 0; k < 2; ++k) \
        acc[ai][bj][m][n] = __builtin_amdgcn_mfma_f32_16x16x32_bf16(Bt[n][k], At[m][k], acc[ai][bj][m][n], 0, 0, 0); __builtin_amdgcn_s_setprio(0); } while (0)
#define PG8_WAIT_V(n) asm volatile("s_waitcnt vmcnt(" #n ")" ::: "memory")
#define PG8_WAIT_L(n) asm volatile("s_waitcnt lgkmcnt(" #n ")" ::: "memory")
#define PG8_BAR __builtin_amdgcn_s_barrier()
#define PG8_SCHED __builtin_amdgcn_sched_barrier(0)

#define PG8_STAGE_A(bufoff, h, nextu, kofs) do { \
        if constexpr (Sched::GATHER) { const char* _g = Ab + (kofs); unsigned _x[2]; \
            _x[0] = (nextu) ? ((h) ? no1[0] : no0[0]) : ((h) ? ao1[0] : ao0[0]); _x[1] = (nextu) ? ((h) ? no1[1] : no0[1]) : ((h) ? ao1[1] : ao0[1]); PG8_STAGE(bufoff, _g, _x); } \
        else { const char* _g = ((nextu) ? nA : cA) + (size_t)(h) * hstep + (kofs); PG8_STAGE(bufoff, _g, voffA); } } while (0)
template <class Epi, class Sched>
__device__ __forceinline__ void gemm_phase(LAS unsigned char* lds, const bf16_t* A, const int K, const Sched& S, const Epi& E, const int wv) {
    int tid = mk_tid(wv); asm volatile("" : "+v"(tid));
    const int wid = __builtin_amdgcn_readfirstlane(tid >> 6), lane = tid & 63, wr = wid >> 2, wc = wid & 3, fr = lane & 15, fq = lane >> 4;
    const int nt = K / BK;
    unsigned voffA[2], voffB[2];
#pragma unroll
    for (int i = 0; i < 2; ++i) { int R, C; stage_rc(tid * 16 + i * 8192, R, C); const int Rb = Epi::PERM ? ((R & ~31) + perm32(R & 31)) : R;
        voffA[i] = (unsigned)(R * K + C) * 2u; voffB[i] = (unsigned)(Rb * K + C) * 2u; }
    const size_t kstep = (size_t)(BK * 2);
    const size_t hstep = (size_t)HALF * K * 2;
    const size_t tstep = 2 * hstep;
    const unsigned ldsw = (unsigned)wid * 1024u;
    const int aoff = lds_byte(wr * 64 + fr, fq * 8), boff = lds_byte(wc * 32 + fr, fq * 8);
    Unit cur, nxt; int ui = 0;
    if (!S.next(0, cur)) return;
    f32x4 acc[2][2][4][2];
#pragma unroll
    for (int a_ = 0; a_ < 2; ++a_)
#pragma unroll
        for (int b_ = 0; b_ < 2; ++b_)
#pragma unroll
            for (int m = 0; m < 4; ++m)
#pragma unroll
                for (int n = 0; n < 2; ++n) acc[a_][b_][m][n] = (f32x4){0.f, 0.f, 0.f, 0.f};
    bf16x8 At[4][2], B0[2][2], B1[2][2];
    unsigned ao0[2] = {0u, 0u}, ao1[2] = {0u, 0u}, no0[2] = {0u, 0u}, no1[2] = {0u, 0u};
    const char* Ab = (const char*)A;
    const char* cA = Ab; const char* nA = Ab;
    if constexpr (Sched::GATHER) {
#pragma unroll
        for (int i = 0; i < 2; ++i) { int R, C; stage_rc(tid * 16 + i * 8192, R, C);
            ao0[i] = (S.arow(cur, R) * (unsigned)K + (unsigned)C) * 2u; ao1[i] = (S.arow(cur, HALF + R) * (unsigned)K + (unsigned)C) * 2u; }
    } else cA = Ab + (size_t)cur.pm * tstep;
    const char* cB = S.bptr(cur);
    PG8_STAGE(PG8_SB(0, 0), cB, voffB); PG8_STAGE_A(PG8_SA(0, 0), 0, false, 0); PG8_STAGE(PG8_SB(0, 1), cB + hstep, voffB); PG8_STAGE_A(PG8_SA(0, 1), 1, false, 0);
    if (wr == 1) PG8_BAR;
    PG8_WAIT_V(4); PG8_BAR;
    PG8_STAGE(PG8_SB(1, 0), cB + kstep, voffB); PG8_STAGE_A(PG8_SA(1, 0), 0, false, kstep); PG8_STAGE(PG8_SB(1, 1), cB + hstep + kstep, voffB);
    PG8_WAIT_V(6); PG8_BAR;
    for (;;) {
        const bool has_next = S.next(ui + 1, nxt);
        const char* nB = has_next ? S.bptr(nxt) : cB;
        if constexpr (Sched::GATHER) {
            if (has_next) {
#pragma unroll
                for (int i = 0; i < 2; ++i) { int R, C; stage_rc(tid * 16 + i * 8192, R, C);
                    no0[i] = (S.arow(nxt, R) * (unsigned)K + (unsigned)C) * 2u; no1[i] = (S.arow(nxt, HALF + R) * (unsigned)K + (unsigned)C) * 2u; }
            } else {
#pragma unroll
                for (int i = 0; i < 2; ++i) { no0[i] = ao0[i]; no1[i] = ao1[i]; }
            }
            asm volatile("s_waitcnt lgkmcnt(0)" ::: "memory");
            asm volatile("" : "+v"(no0[0]), "+v"(no0[1]), "+v"(no1[0]), "+v"(no1[1]));
        } else nA = has_next ? Ab + (size_t)nxt.pm * tstep : cA;
        for (int t = 0; t < nt; t += 2) {
            const bool last = (t == nt - 2);
            const size_t k1 = (size_t)(t + 1) * kstep;
            const size_t k2 = last ? 0 : (size_t)(t + 2) * kstep, k3 = k2 + kstep;
            const char* b2 = last ? nB : cB + (size_t)(t + 2) * kstep; const char* b3 = b2 + kstep;
            PG8_LDB(B0, 0, 0); PG8_SCHED; PG8_LDA(At, 0, 0); PG8_STAGE_A(PG8_SA(1, 1), 1, false, k1);
            PG8_WAIT_L(8); PG8_BAR; PG8_WAIT_L(0); PG8_MMA(0, 0, At, B0); PG8_BAR; PG8_SCHED;
            PG8_LDB(B1, 0, 1); PG8_STAGE(PG8_SB(0, 0), b2, voffB);
            PG8_BAR; PG8_WAIT_L(0); PG8_MMA(0, 1, At, B1); PG8_BAR;
            PG8_LDA(At, 0, 1); PG8_STAGE_A(PG8_SA(0, 0), 0, last, k2);
            PG8_BAR; PG8_WAIT_L(0); PG8_MMA(1, 0, At, B0); PG8_BAR; PG8_SCHED;
            PG8_STAGE(PG8_SB(0, 1), b2 + hstep, voffB);
            PG8_WAIT_V(6); PG8_BAR; PG8_MMA(1, 1, At, B1); PG8_BAR;
            PG8_LDB(B0, 1, 0); PG8_SCHED; PG8_LDA(At, 1, 0); PG8_STAGE_A(PG8_SA(0, 1), 1, last, k2);
            PG8_WAIT_L(8); PG8_BAR; PG8_WAIT_L(0); PG8_MMA(0, 0, At, B0); PG8_BAR; PG8_SCHED;
            PG8_LDB(B1, 1, 1); PG8_STAGE(PG8_SB(1, 0), b3, voffB);
            PG8_BAR; PG8_WAIT_L(0); PG8_MMA(0, 1, At, B1); PG8_BAR;
            PG8_LDA(At, 1, 1); PG8_STAGE_A(PG8_SA(1, 0), 0, last, k3);
            PG8_BAR; PG8_WAIT_L(0); PG8_MMA(1, 0, At, B0); PG8_BAR; PG8_SCHED;
            PG8_STAGE(PG8_SB(1, 1), b3 + hstep, voffB);
            PG8_WAIT_V(6); PG8_BAR; PG8_MMA(1, 1, At, B1); PG8_BAR;
        }
        E(acc, cur, wr, wc, fr, fq);
        if (!has_next) break;
#pragma unroll
        for (int a_ = 0; a_ < 2; ++a_)
#pragma unroll
            for (int b_ = 0; b_ < 2; ++b_)
#pragma unroll
                for (int m = 0; m < 4; ++m)
#pragma unroll
                    for (int n = 0; n < 2; ++n) acc[a_][b_][m][n] = (f32x4){0.f, 0.f, 0.f, 0.f};
        cur = nxt; cB = nB; cA = nA; ++ui;
#pragma unroll
        for (int i = 0; i < 2; ++i) { ao0[i] = no0[i]; ao1[i] = no1[i]; }
    }
    PG8_WAIT_V(0);
    if (wr == 0) PG8_BAR;
    PG8_BAR;
}

struct EpiInProj {
    static constexpr bool PERM = true;
    unsigned char* ws; float* kmean; const float* rope; const float* bcum;
    __device__ __forceinline__ void operator()(const f32x4 (&acc)[2][2][4][2], const Unit& u, int wr, int wc, int fr, int fq) const {
        const int row0 = u.pm * BM + wr * 64 + fr;
        const int lc = wc * 32 + 8 * fq;
        if (u.pn < 8) {
            const bool isq = u.pn < 4;
            bf16_t* dst = (bf16_t*)(ws + (isq ? WS_Q : WS_K));
            const int cb = (u.pn & 3) * 256;
            const float scale = isq ? QSCALE : 1.0f;
            float ks[2][8];
#pragma unroll
            for (int bj = 0; bj < 2; ++bj)
#pragma unroll
                for (int i = 0; i < 8; ++i) ks[bj][i] = 0.f;
            f32x4 rc[2][4];
#define ROPE_LOAD(buf, g) do { const int _pos = (row0 + ((g) >> 2) * HALF + ((g) & 3) * 16) & (SEQ - 1); const float* _rp = rope + _pos * 32 + 8 * (fq & 1); \
                rc[buf][0] = *(const f32x4*)_rp; rc[buf][1] = *(const f32x4*)(_rp + 4); rc[buf][2] = *(const f32x4*)(_rp + 16); rc[buf][3] = *(const f32x4*)(_rp + 20); } while (0)
            if (wc == 0) ROPE_LOAD(0, 0);
#pragma unroll
            for (int g = 0; g < 8; ++g) {
                const int ai = g >> 2, m = g & 3;
                const int r = row0 + ai * HALF + m * 16;
                if (wc == 0 && g + 1 < 8) ROPE_LOAD((g + 1) & 1, g + 1);
#pragma unroll
                for (int bj = 0; bj < 2; ++bj) {
                    float v[8] = {acc[ai][bj][m][0][0], acc[ai][bj][m][0][1], acc[ai][bj][m][0][2], acc[ai][bj][m][0][3],
                                  acc[ai][bj][m][1][0], acc[ai][bj][m][1][1], acc[ai][bj][m][1][2], acc[ai][bj][m][1][3]};
                    if (wc == 0) {
                        const f32x4 c0 = rc[g & 1][0], c1 = rc[g & 1][1], s0 = rc[g & 1][2], s1 = rc[g & 1][3];
                        const float cs[8] = {c0[0], c0[1], c0[2], c0[3], c1[0], c1[1], c1[2], c1[3]}, sn[8] = {s0[0], s0[1], s0[2], s0[3], s1[0], s1[1], s1[2], s1[3]};
#pragma unroll
                        for (int i = 0; i < 8; ++i) {
                            const float pv = __shfl_xor(v[i], 32);
                            v[i] = (fq < 2) ? (v[i] * cs[i] - pv * sn[i]) : (v[i] * cs[i] + pv * sn[i]);
                        }
                    }
                    if (!isq) {
#pragma unroll
                        for (int i = 0; i < 8; ++i) ks[bj][i] += v[i];
                    }
                    u32x4 o; o[0] = cvt_pk_bf16(v[0] * scale, v[1] * scale); o[1] = cvt_pk_bf16(v[2] * scale, v[3] * scale);
                    o[2] = cvt_pk_bf16(v[4] * scale, v[5] * scale); o[3] = cvt_pk_bf16(v[6] * scale, v[7] * scale);
                    __builtin_nontemporal_store(o, (u32x4*)(dst + ((size_t)((r >> 11) * 8 + (u.pn & 3) * 2 + bj) * SEQ + (r & (SEQ - 1))) * 128 + lc));
                }
            }
#undef ROPE_LOAD
            if (!isq) {
                const int b = u.pm >> 3, blk = u.pm & 7;
#pragma unroll
                for (int bj = 0; bj < 2; ++bj) {
                    const int h = (u.pn & 3) * 2 + bj;
#pragma unroll
                    for (int i = 0; i < 8; ++i) {
                        float s = ks[bj][i];
                        s += __shfl_xor(s, 1); s += __shfl_xor(s, 2); s += __shfl_xor(s, 4); s += __shfl_xor(s, 8);
                        if (fr == 0) atomicAdd(kmean + (((size_t)b * 8 + h) * 8 + blk) * 128 + lc + i, s * (1.0f / 256.0f));
                    }
                }
            }
        } else if (u.pn < 12) {
            bf16_t* dst = (bf16_t*)(ws + WS_VT);
#pragma unroll
            for (int ai = 0; ai < 2; ++ai)
#pragma unroll
                for (int m = 0; m < 4; ++m) {
                    const int r = row0 + ai * HALF + m * 16;
#pragma unroll
                    for (int bj = 0; bj < 2; ++bj) {
                        const f32x4 v0 = acc[ai][bj][m][0], v1 = acc[ai][bj][m][1];
                        u32x4 o; o[0] = cvt_pk_bf16(v0[0], v0[1]); o[1] = cvt_pk_bf16(v0[2], v0[3]); o[2] = cvt_pk_bf16(v1[0], v1[1]); o[3] = cvt_pk_bf16(v1[2], v1[3]);
                        __builtin_nontemporal_store(o, (u32x4*)(dst + ((size_t)((r >> 11) * 8 + (u.pn - 8) * 2 + bj) * SEQ + (r & (SEQ - 1))) * 128 + lc));
                    }
                }
        } else if (u.pn < 16) {
            const bool isq = u.pn < 14;
            const int cb = (u.pn - (isq ? 12 : 14)) * 256;
            bf16_t* d0 = (bf16_t*)(ws + (isq ? WS_QG : WS_KG));
            f32x4 bc[2][2];
#define BC_LOAD(buf, g) do { const int _r = row0 + ((g) >> 3) * HALF + (((g) >> 1) & 3) * 16, _col = cb + ((g) & 1) * HALF + lc; \
                bc[buf][0] = *(const f32x4*)(bcum + (size_t)_r * 512 + _col); bc[buf][1] = *(const f32x4*)(bcum + (size_t)_r * 512 + _col + 4); } while (0)
            BC_LOAD(0, 0);
#pragma unroll
            for (int g = 0; g < 16; ++g) {
                const int ai = g >> 3, m = (g >> 1) & 3, bj = g & 1;
                const int r = row0 + ai * HALF + m * 16;
                if (g + 1 < 16) BC_LOAD((g + 1) & 1, g + 1);
                {
                    {
                        const int col = cb + bj * HALF + lc;
                        const size_t hoff = ((size_t)((r >> 11) * 4 + (col >> 7)) * SEQ + (r & (SEQ - 1))) * 128 + (col & 127);
                        const f32x4 b0 = bc[g & 1][0], b1 = bc[g & 1][1];
                        const f32x4 v0 = acc[ai][bj][m][0], v1 = acc[ai][bj][m][1];
                        const float L2E = 1.4426950408889634f;
                        if (isq) {
                            const float s = 0.08838834764831845f;
                            u32x4 o; o[0] = cvt_pk_bf16(v0[0] * s * __builtin_amdgcn_exp2f(b0[0] * L2E), v0[1] * s * __builtin_amdgcn_exp2f(b0[1] * L2E));
                            o[1] = cvt_pk_bf16(v0[2] * s * __builtin_amdgcn_exp2f(b0[2] * L2E), v0[3] * s * __builtin_amdgcn_exp2f(b0[3] * L2E));
                            o[2] = cvt_pk_bf16(v1[0] * s * __builtin_amdgcn_exp2f(b1[0] * L2E), v1[1] * s * __builtin_amdgcn_exp2f(b1[1] * L2E));
                            o[3] = cvt_pk_bf16(v1[2] * s * __builtin_amdgcn_exp2f(b1[2] * L2E), v1[3] * s * __builtin_amdgcn_exp2f(b1[3] * L2E));
                            __builtin_nontemporal_store(o, (u32x4*)(d0 + hoff));
                        } else {
                            u32x4 o;
                            o[0] = cvt_pk_bf16(v0[0] * __builtin_amdgcn_exp2f(-b0[0] * L2E), v0[1] * __builtin_amdgcn_exp2f(-b0[1] * L2E));
                            o[1] = cvt_pk_bf16(v0[2] * __builtin_amdgcn_exp2f(-b0[2] * L2E), v0[3] * __builtin_amdgcn_exp2f(-b0[3] * L2E));
                            o[2] = cvt_pk_bf16(v1[0] * __builtin_amdgcn_exp2f(-b1[0] * L2E), v1[1] * __builtin_amdgcn_exp2f(-b1[1] * L2E));
                            o[3] = cvt_pk_bf16(v1[2] * __builtin_amdgcn_exp2f(-b1[2] * L2E), v1[3] * __builtin_amdgcn_exp2f(-b1[3] * L2E));
                            __builtin_nontemporal_store(o, (u32x4*)(d0 + hoff));
                        }
                    }
                }
            }
#undef BC_LOAD
        } else {
            const bool isog = u.pn >= 20;
            size_t woff; int cb;
            if (u.pn < 20) { woff = WS_VG; cb = (u.pn - 16) * 256; }
            else { woff = WS_OG; cb = (u.pn - 20) * 256; }
            bf16_t* dst = (bf16_t*)(ws + woff);
#pragma unroll
            for (int ai = 0; ai < 2; ++ai)
#pragma unroll
                for (int m = 0; m < 4; ++m) {
                    const int r = row0 + ai * HALF + m * 16;
#pragma unroll
                    for (int bj = 0; bj < 2; ++bj) {
                        f32x4 v0 = acc[ai][bj][m][0], v1 = acc[ai][bj][m][1];
                        if (isog) {
#pragma unroll
                            for (int i = 0; i < 4; ++i) { v0[i] = silu_fast(v0[i]); v1[i] = silu_fast(v1[i]); }
                        }
                        u32x4 o; o[0] = cvt_pk_bf16(v0[0], v0[1]); o[1] = cvt_pk_bf16(v0[2], v0[3]); o[2] = cvt_pk_bf16(v1[0], v1[1]); o[3] = cvt_pk_bf16(v1[2], v1[3]);
                        __builtin_nontemporal_store(o, (u32x4*)(dst + ((size_t)((r >> 11) * 4 + (cb >> 8)) * SEQ + (r & (SEQ - 1))) * 256 + bj * HALF + lc));
                    }
                }
        }
    }
};
struct EpiResGate {
    static constexpr bool PERM = false;
    const float* res; float* out; const float* gate;
    __device__ __forceinline__ void operator()(const f32x4 (&acc)[2][2][4][2], const Unit& u, int wr, int wc, int fr, int fq) const {
        const int row0 = u.pm * BM + wr * 64 + fr, col0 = u.pn * BM + wc * 32 + 4 * fq;
        const int b = u.pm >> 3;
        f32x4 gv[2][2];
#pragma unroll
        for (int bj = 0; bj < 2; ++bj)
#pragma unroll
            for (int n = 0; n < 2; ++n) gv[bj][n] = *(const f32x4*)(gate + (size_t)b * (6 * DM) + col0 + bj * HALF + n * 16);
#pragma unroll
        for (int ai = 0; ai < 2; ++ai) {
            f32x4 rv[4][2][2];
#pragma unroll
            for (int m = 0; m < 4; ++m) { const size_t off = (size_t)(row0 + ai * HALF + m * 16) * DM + col0;
#pragma unroll
                for (int bj = 0; bj < 2; ++bj)
#pragma unroll
                    for (int n = 0; n < 2; ++n) rv[m][bj][n] = *(const f32x4*)(res + off + bj * HALF + n * 16); }
#pragma unroll
            for (int m = 0; m < 4; ++m) { const size_t off = (size_t)(row0 + ai * HALF + m * 16) * DM + col0;
#pragma unroll
                for (int bj = 0; bj < 2; ++bj)
#pragma unroll
                    for (int n = 0; n < 2; ++n) *(f32x4*)(out + off + bj * HALF + n * 16) = rv[m][bj][n] + gv[bj][n] * acc[ai][bj][m][n]; }
            asm volatile("" ::: "memory");
        }
    }
};
struct MoeOrder {
    static constexpr bool GATHER = true;
    const int* slot; const bf16_t* Bt; int K, G, c, a_shift; const LAS int* tb;
    LAS int* rowtab;
    __device__ __forceinline__ bool next(int i, Unit& u) const {
        const int L = i * G + c, total = tb[32] * 8; if (L >= total || i >= 8) return false;
        const int mt = L >> 3; int e = 0;
        for (int j = 1; j < 32; ++j) e = (tb[j] <= mt) ? j : e;
        e = __builtin_amdgcn_readfirstlane(e);
        u.e = e; u.pm = mt - tb[e]; u.pn = L & 7; u.ui = i;
        const int rem = tb[33 + e] - u.pm * 256; u.rows = rem < 256 ? rem : 256; return true;
    }
    __device__ __forceinline__ const char* bptr(const Unit& u) const { return (const char*)Bt + ((size_t)u.e * 2048 + (size_t)u.pn * 256) * K * 2; }
    __device__ __forceinline__ unsigned arow(const Unit& u, int r) const { return (unsigned)(rowtab[u.ui * 256 + r] >> a_shift); }
    __device__ __forceinline__ void fill_rows(const int tid) const {
        Unit u;
        for (int i = 0; i < 8 && next(i, u); ++i)
            if (tid < 256) rowtab[i * 256 + tid] = slot[(size_t)u.e * ECAP + u.pm * 256 + (tid < u.rows ? tid : 0)];
        __syncthreads();
    }
};
__device__ __forceinline__ void moe_tiles(const int* cnt, LAS int* tb, const int wv) {
    if (mk_tid(wv) == 0) { int acc = 0; for (int e = 0; e < 32; ++e) { const int c = cnt[e]; tb[e] = acc; tb[33 + e] = c; acc += (c + 255) >> 8; } tb[32] = acc; }
    __syncthreads();
}
struct EpiMoe1 {
    static constexpr bool PERM = true;
    const LAS int* rowtab; bf16_t* act;
    __device__ __forceinline__ void operator()(const f32x4 (&acc)[2][2][4][2], const Unit& u, int wr, int wc, int fr, int fq) const {
        const int lc = u.pn * 128 + wc * 32 + 8 * fq;
#pragma unroll
        for (int ai = 0; ai < 2; ++ai)
#pragma unroll
            for (int m = 0; m < 4; ++m) {
                const int r = ai * HALF + wr * 64 + m * 16 + fr;
                if (r < u.rows) {
                    const int asg = rowtab[u.ui * 256 + r];
                    float o[8];
#pragma unroll
                    for (int n = 0; n < 2; ++n)
#pragma unroll
                        for (int j = 0; j < 4; ++j) { const float g = acc[ai][0][m][n][j], up = acc[ai][1][m][n][j]; o[4 * n + j] = silu_fast(g) * up; }
                    u32x4 w; w[0] = cvt_pk_bf16(o[0], o[1]); w[1] = cvt_pk_bf16(o[2], o[3]); w[2] = cvt_pk_bf16(o[4], o[5]); w[3] = cvt_pk_bf16(o[6], o[7]);
                    *(u32x4*)(act + (size_t)asg * DEXP + lc) = w;
                }
            }
    }
};
struct EpiMoe2 {
    static constexpr bool PERM = true;
    const LAS int* rowtab; bf16_t* yb;
    __device__ __forceinline__ void operator()(const f32x4 (&acc)[2][2][4][2], const Unit& u, int wr, int wc, int fr, int fq) const {
        const int lc = u.pn * 256 + wc * 32 + 8 * fq;
#pragma unroll
        for (int ai = 0; ai < 2; ++ai)
#pragma unroll
            for (int m = 0; m < 4; ++m) {
                const int r = ai * HALF + wr * 64 + m * 16 + fr;
                if (r < u.rows) {
                    const int asg = rowtab[u.ui * 256 + r];
#pragma unroll
                    for (int bj = 0; bj < 2; ++bj) {
                        const f32x4 v0 = acc[ai][bj][m][0], v1 = acc[ai][bj][m][1];
                        u32x4 w; w[0] = cvt_pk_bf16(v0[0], v0[1]); w[1] = cvt_pk_bf16(v0[2], v0[3]); w[2] = cvt_pk_bf16(v1[0], v1[1]); w[3] = cvt_pk_bf16(v1[2], v1[3]);
                        *(u32x4*)(yb + (size_t)asg * DM + lc + bj * HALF) = w;
                    }
                }
            }
    }
};
}

namespace attn {
typedef float f32x16 __attribute__((ext_vector_type(16)));
typedef short s16x4 __attribute__((ext_vector_type(4)));
constexpr int KSTR = 272, VSTR = 320, KT_BYTES = 64 * KSTR, VT_BYTES = 64 * VSTR;
constexpr int L_KM = 0, L_K = 4096, L_V = L_K + 2 * KT_BYTES, L_END = L_V + 2 * VT_BYTES;

__device__ __forceinline__ float bf2f(short s) { return __uint_as_float(((unsigned)(unsigned short)s) << 16); }

__device__ __forceinline__ void attn_unit(LAS unsigned char* lds, const bf16_t* Q, const bf16_t* K, const bf16_t* Vt, const float* kmean, bf16_t* mix,
                                          const int b, const int h, const int blk, const int wv) {
    int tid = mk_tid(wv); asm volatile("" : "+v"(tid));
    const int w = __builtin_amdgcn_readfirstlane(tid >> 6), lane = tid & 63, j = lane & 31, hh = lane >> 5;
    LAS float* km = (LAS float*)(lds + L_KM);
    __syncthreads();
    {
        const float* kp = kmean + ((size_t)(b * 8 + h) * 8) * 128;
        km[2 * tid] = kp[2 * tid]; km[2 * tid + 1] = kp[2 * tid + 1];
    }
    const size_t qrow = (size_t)b * SEQ + blk * 256 + 32 * w + j;
    const size_t hbase = (size_t)(b * 8 + h) * SEQ;
    bf16x8 qf[8];
#pragma unroll
    for (int ks = 0; ks < 8; ++ks) qf[ks] = *(const bf16x8*)(Q + (hbase + blk * 256 + 32 * w + j) * 128 + 16 * ks + 8 * hh);
    const int ntile = 4 + 4 * blk;
    u32x4 krA[2], vrA[2], krB[2], vrB[2];
#define ATT_KEY0(ti) (((ti) < 4) ? (blk * 256 + 64 * (ti)) : ((((ti) - 4) >> 2) * 256 + 64 * (((ti) - 4) & 3)))
#define ATT_LOAD(kr, vr, ti) do { const int _k0 = ATT_KEY0(ti); _Pragma("unroll") for (int _i = 0; _i < 2; ++_i) { const int _c = tid + 512 * _i; \
        kr[_i] = *(const u32x4*)(K + (hbase + _k0) * 128 + (size_t)_c * 8); \
        vr[_i] = *(const u32x4*)(Vt + (hbase + _k0) * 128 + (size_t)_c * 8); } } while (0)
#define ATT_STORE(kr, vr, buf) do { _Pragma("unroll") for (int _i = 0; _i < 2; ++_i) { const int _c = tid + 512 * _i; \
        *(LAS u32x4*)(lds + L_K + (buf) * KT_BYTES + (_c >> 4) * KSTR + (_c & 15) * 16) = kr[_i]; \
        *(LAS u32x4*)(lds + L_V + (buf) * VT_BYTES + (_c >> 4) * VSTR + (_c & 15) * 16) = vr[_i]; } } while (0)
    ATT_LOAD(krA, vrA, 0);
    __syncthreads();
    unsigned sel = 0u;
    {
        float g[7];
#pragma unroll
        for (int n = 0; n < 7; ++n) {
            float p = 0.f;
            if (n < blk) {
#pragma unroll
                for (int ks = 0; ks < 8; ++ks) {
                    const f32x4 k0 = *(const LAS f32x4*)&km[n * 128 + 16 * ks + 8 * hh], k1 = *(const LAS f32x4*)&km[n * 128 + 16 * ks + 8 * hh + 4];
                    p += bf2f(qf[ks][0]) * k0[0] + bf2f(qf[ks][1]) * k0[1] + bf2f(qf[ks][2]) * k0[2] + bf2f(qf[ks][3]) * k0[3]
                       + bf2f(qf[ks][4]) * k1[0] + bf2f(qf[ks][5]) * k1[1] + bf2f(qf[ks][6]) * k1[2] + bf2f(qf[ks][7]) * k1[3];
                }
            }
            g[n] = p + __shfl_xor(p, 32);
        }
#pragma unroll
        for (int n = 0; n < 7; ++n) {
            int rank = 0;
#pragma unroll
            for (int m2 = 0; m2 < 7; ++m2) if (m2 != n && m2 < blk) rank += (g[m2] > g[n] || (g[m2] == g[n] && m2 < n)) ? 1 : 0;
            if (n < blk && rank < 3) sel |= 1u << n;
        }
    }
    ATT_STORE(krA, vrA, 0);
    if (ntile > 1) ATT_LOAD(krA, vrA, 1);
    __syncthreads();
    f32x16 o[4];
#pragma unroll
    for (int d = 0; d < 4; ++d)
#pragma unroll
        for (int r = 0; r < 16; ++r) o[d][r] = 0.f;
    float mrun = -1e30f, lsum = 0.f;
#define ATT_TILE(TI, KX, VX, KY, VY) do { const int ti = (TI); \
        const int buf = ti & 1; \
        if (ti + 2 < ntile) ATT_LOAD(KY, VY, ti + 2); \
        bool active, diag = false, lsel = true; \
        if (ti < 4) { active = (ti <= (w >> 1)); diag = (ti == (w >> 1)); } \
        else { lsel = ((sel >> ((ti - 4) >> 2)) & 1u) != 0u; active = __builtin_amdgcn_ballot_w64(lsel) != 0ull; } \
        if (active) { \
            f32x16 s0, s1; \
_Pragma("unroll") \
            for (int r = 0; r < 16; ++r) { s0[r] = 0.f; s1[r] = 0.f; } \
            const LAS unsigned char* kb = lds + L_K + buf * KT_BYTES + j * KSTR + hh * 16; \
_Pragma("unroll") \
            for (int ks = 0; ks < 8; ++ks) { \
                const bf16x8 a0 = *(const LAS bf16x8*)(kb + ks * 32), a1 = *(const LAS bf16x8*)(kb + 32 * KSTR + ks * 32); \
                s0 = __builtin_amdgcn_mfma_f32_32x32x16_bf16(a0, qf[ks], s0, 0, 0, 0); \
                s1 = __builtin_amdgcn_mfma_f32_32x32x16_bf16(a1, qf[ks], s1, 0, 0, 0); \
            } \
            const LAS unsigned char* vb = lds + L_V + buf * VT_BYTES + (((lane & 15) >> 2) + 4 * hh) * VSTR + (16 * ((lane >> 4) & 1) + 4 * (lane & 3)) * 2; \
_Pragma("unroll") \
            for (int u = 0; u < 2; ++u) { \
                f32x16& sx = u ? s1 : s0; \
                if (diag) { \
                    const int ql = 32 * w + j - 64 * ti - 32 * u; \
_Pragma("unroll") \
                    for (int r = 0; r < 16; ++r) { const int kr_ = (r & 3) + 8 * (r >> 2) + 4 * hh; if (kr_ > ql) sx[r] = -INFINITY; } \
                } \
                if (!lsel) { \
_Pragma("unroll") \
                    for (int r = 0; r < 16; ++r) sx[r] = -INFINITY; \
                } \
                float mnew = mrun, alpha = 1.0f; \
                if (ti < 4) { \
                    float mx = sx[0]; \
_Pragma("unroll") \
                    for (int r = 1; r < 16; ++r) mx = fmaxf(mx, sx[r]); \
                    mx = fmaxf(mx, __shfl_xor(mx, 32)); \
                    mnew = fmaxf(mrun, mx); alpha = __builtin_amdgcn_exp2f(mrun - mnew); mrun = mnew; \
                } \
                float ps = 0.f; \
_Pragma("unroll") \
                for (int r = 0; r < 16; ++r) { sx[r] = __builtin_amdgcn_exp2f(sx[r] - mnew); ps += sx[r]; } \
                lsum = lsum * alpha + ps; \
                if (ti < 4 && __builtin_amdgcn_ballot_w64(alpha != 1.0f) != 0ull) { \
_Pragma("unroll") \
                    for (int d = 0; d < 4; ++d) \
_Pragma("unroll") \
                        for (int r = 0; r < 16; ++r) o[d][r] *= alpha; \
                } \
                bf16x8 pk[2]; \
_Pragma("unroll") \
                for (int s2 = 0; s2 < 2; ++s2) { \
                    u32x4 t0; \
_Pragma("unroll") \
                    for (int e = 0; e < 4; ++e) t0[e] = cvt_pk_bf16(sx[8 * s2 + 2 * e], sx[8 * s2 + 2 * e + 1]); \
                    pk[s2] = __builtin_bit_cast(bf16x8, t0); \
                } \
_Pragma("unroll") \
                for (int d = 0; d < 4; ++d) \
_Pragma("unroll") \
                    for (int s2 = 0; s2 < 2; ++s2) { \
                        const LAS unsigned char* vp = vb + (32 * u + 16 * s2) * VSTR + d * 64; \
                        const s16x4 x0 = __builtin_amdgcn_ds_read_tr16_b64_v4i16((LAS s16x4*)vp), x1 = __builtin_amdgcn_ds_read_tr16_b64_v4i16((LAS s16x4*)(vp + 8 * VSTR)); \
                        const bf16x8 av = (bf16x8){x0[0], x0[1], x0[2], x0[3], x1[0], x1[1], x1[2], x1[3]}; \
                        o[d] = __builtin_amdgcn_mfma_f32_32x32x16_bf16(av, pk[s2], o[d], 0, 0, 0); \
                    } \
            } \
        } \
        if (ti + 1 < ntile) ATT_STORE(KX, VX, buf ^ 1); \
        __syncthreads(); \
    } while (0)
    for (int t2 = 0; t2 < ntile; t2 += 2) {
        ATT_TILE(t2, krA, vrA, krB, vrB);
        if (t2 + 1 < ntile) ATT_TILE(t2 + 1, krB, vrB, krA, vrA);
    }
#undef ATT_TILE
#undef ATT_LOAD
#undef ATT_KEY0
#undef ATT_STORE
    lsum += __shfl_xor(lsum, 32);
    const float inv = 1.0f / lsum;
    bf16_t* op = mix + qrow * DM + h * 128 + 4 * hh;
#pragma unroll
    for (int d = 0; d < 4; ++d)
#pragma unroll
        for (int rg = 0; rg < 4; ++rg) {
            u32x2 wv; wv[0] = cvt_pk_bf16(o[d][4 * rg] * inv, o[d][4 * rg + 1] * inv); wv[1] = cvt_pk_bf16(o[d][4 * rg + 2] * inv, o[d][4 * rg + 3] * inv);
            *(u32x2*)(op + 32 * d + 8 * rg) = wv;
        }
}

__device__ __forceinline__ void attn_phase(LAS unsigned char* lds, const unsigned char* ws, unsigned* queue, const int l, const int wv) {
    const bf16_t* Q = (const bf16_t*)(ws + WS_Q); const bf16_t* K = (const bf16_t*)(ws + WS_K); const bf16_t* Vt = (const bf16_t*)(ws + WS_VT);
    const float* kmean = (const float*)(ws + WS_KMEAN) + (size_t)l * 8 * 8 * 8 * 128;
    bf16_t* mix = (bf16_t*)(ws + WS_MIX);
    LAS int* slot = (LAS int*)(lds + L_END);
    for (;;) {
        __syncthreads();
        if (mk_tid(wv) == 0) *slot = (int)atomicAdd(queue, 1u);
        __syncthreads();
        const int u = *slot;
        if (u >= 512) break;
        const int blk = 7 - (u >> 6), bh = u & 63;
        attn_unit(lds, Q, K, Vt, kmean, mix, bh >> 3, bh & 7, blk, wv);
    }
}
__device__ __forceinline__ void attn_cvt_phase(const MkArgs& a, LAS unsigned char* lds, unsigned* aqueue, unsigned* cqueue, const int l, const int clo, const int chi, const int cper, const int wv) {
    const unsigned char* ws = a.ws;
    const bf16_t* Q = (const bf16_t*)(ws + WS_Q); const bf16_t* K = (const bf16_t*)(ws + WS_K); const bf16_t* Vt = (const bf16_t*)(ws + WS_VT);
    const float* kmean = (const float*)(ws + WS_KMEAN) + (size_t)l * 8 * 8 * 8 * 128;
    bf16_t* mix = (bf16_t*)(ws + WS_MIX);
    LAS int* slot = (LAS int*)(lds + L_END);
    bool adone = false, cdone = (clo >= chi);
    int turn = (int)blockIdx.x & 1;
    while (!(adone && cdone)) {
        if (turn == 0) {
            if (!adone) {
                __syncthreads();
                if (mk_tid(wv) == 0) *slot = (int)atomicAdd(aqueue, 1u);
                __syncthreads();
                const int u = *slot;
                if (u >= 512) adone = true;
                else {
                    int blk, bh;
                    if (u < 320) { bh = u / 5; blk = 7 - (u - 5 * bh); } else { const int v = u - 320; blk = 2 - (v >> 6); bh = v & 63; }
                    attn_unit(lds, Q, K, Vt, kmean, mix, bh >> 3, bh & 7, blk, wv); }
            }
        } else if (!cdone) {
            __syncthreads();
            if (mk_tid(wv) == 0) *slot = clo + (int)atomicAdd(cqueue, (unsigned)cper);
            __syncthreads();
            const int base = *slot;
            if (base >= chi) cdone = true;
            else { int tid = mk_tid(wv); asm volatile("" : "+v"(tid)); cvt_range(a, lds, tid, base, 1, (base + cper < chi) ? base + cper : chi, true); }
        }
        turn ^= 1;
    }
}
}

namespace gla {
typedef float f32x16 __attribute__((ext_vector_type(16)));
typedef short s16x4 __attribute__((ext_vector_type(4)));
constexpr int QS = 272, ES = 320, VS = 576, OS = 260;
constexpr int L_Q = 0, L_K = L_Q + 64 * QS, L_OB = 0, L_KE = 64 * OS * 4, L_V = L_KE + 64 * ES, L_FR = L_V + 64 * VS, L_DEC = L_FR + 3 * 2 * 64 * 16, L_GON = L_DEC + 512, L_END = L_GON + 1024;
static_assert(L_K + 64 * QS <= L_KE, "obuf (f32 [64][OS]) covers q~ and k~, which are dead when it is written");
static_assert(L_END <= 160 * 1024 - 64, "LDS budget");

__device__ __forceinline__ bf16x8 ld2x64(const LAS unsigned char* p) {
    const u32x2 lo = *(const LAS u32x2*)p, hi = *(const LAS u32x2*)(p + 16);
    return __builtin_bit_cast(bf16x8, (u32x4){lo[0], lo[1], hi[0], hi[1]});
}
__device__ __forceinline__ bf16x8 tr8(const LAS unsigned char* p0, const LAS unsigned char* p1) {
    const s16x4 a = __builtin_amdgcn_ds_read_tr16_b64_v4i16((LAS s16x4*)p0), b = __builtin_amdgcn_ds_read_tr16_b64_v4i16((LAS s16x4*)p1);
    return (bf16x8){a[0], a[1], a[2], a[3], b[0], b[1], b[2], b[3]};
}
__device__ __forceinline__ bf16x8 pack8(const f32x16& x, const int s2) {
    u32x4 t;
#pragma unroll
    for (int e = 0; e < 4; ++e) t[e] = cvt_pk_bf16(x[8 * s2 + 2 * e], x[8 * s2 + 2 * e + 1]);
    return __builtin_bit_cast(bf16x8, t);
}

__device__ __forceinline__ void gla_unit(LAS unsigned char* lds, const unsigned char* ws, const float* g_onorm, const int b, const int h, const int wv) {
    int tid = mk_tid(wv); asm volatile("" : "+v"(tid));
    const int w = __builtin_amdgcn_readfirstlane(tid >> 6), lane = tid & 63, j = lane & 31, hh = lane >> 5;
    const bf16_t* QG = (const bf16_t*)(ws + WS_QG); const bf16_t* KG = (const bf16_t*)(ws + WS_KG);
    const bf16_t* VG = (const bf16_t*)(ws + WS_VG); const bf16_t* OG = (const bf16_t*)(ws + WS_OG);
    const float* BC = (const float*)(ws + WS_LA); bf16_t* mix = (bf16_t*)(ws + WS_MIX);
    LAS float* dec = (LAS float*)(lds + L_DEC); LAS float* gon = (LAS float*)(lds + L_GON); LAS float* obuf = (LAS float*)(lds + L_OB);
    f32x16 S[4];
#pragma unroll
    for (int et = 0; et < 4; ++et)
#pragma unroll
        for (int r = 0; r < 16; ++r) S[et][r] = 0.f;
    __syncthreads();
    if (tid < 256) gon[tid] = g_onorm[tid];
    u32x4 qr[2][2], kr[2][2], vr[2][4], ogr[4]; f32x4 dr = (f32x4){0.f, 0.f, 0.f, 0.f};
    const unsigned o16 = (unsigned)tid * 16u, oog = (unsigned)tid * 64u;
#define GLA_LOAD(ps, n) do { const size_t _t0 = ((size_t)(b * 4 + h) * SEQ + 64 * (n)); \
        const char* _qb = (const char*)(QG + _t0 * 128); const char* _kb = (const char*)(KG + _t0 * 128); \
        const char* _vb = (const char*)(VG + _t0 * 256); \
        _Pragma("unroll") for (int _i = 0; _i < 2; ++_i) { qr[ps][_i] = *(const u32x4*)(_qb + _i * 8192 + o16); kr[ps][_i] = *(const u32x4*)(_kb + _i * 8192 + o16); } \
        _Pragma("unroll") for (int _i = 0; _i < 4; ++_i) vr[ps][_i] = *(const u32x4*)(_vb + _i * 8192 + o16); \
        } while (0)
#define GLA_LOAD_DR(n) do { if (tid < 32) dr = *(const f32x4*)(BC + ((size_t)b * SEQ + 64 * (n) + 63) * 512 + h * 128 + tid * 4); } while (0)
    const LAS unsigned char* qb8 = lds + L_Q + j * QS + hh * 8;  const LAS unsigned char* qb16 = lds + L_Q + j * QS + hh * 16;
    const LAS unsigned char* kb16 = lds + L_K + j * QS + hh * 16;
    const int li = lane & 15, gq = li >> 2, gp = li & 3, gg = (lane >> 4) & 1;
    const LAS unsigned char* keN = lds + L_KE + (gq + 8 * hh) * ES + (16 * gg + 4 * gp) * 2;
    const LAS unsigned char* vN = lds + L_V + (gq + 8 * hh) * VS + (32 * w + 16 * gg + 4 * gp) * 2;
    const LAS unsigned char* vP = lds + L_V + (gq + 4 * hh) * VS + (32 * w + 16 * gg + 4 * gp) * 2;
    const LAS float* decb = dec + 4 * hh; LAS float* ob = obuf + 4 * hh * OS + 32 * w + j;
    LAS unsigned char* frb = lds + L_FR + lane * 16;
#define GLA_LOAD_OG(ps, n) do { const char* _ob = (const char*)(OG + ((size_t)(b * 4 + h) * SEQ + 64 * (n)) * 256); \
        _Pragma("unroll") for (int x = 0; x < 4; ++x) ogr[x] = *(const u32x4*)(_ob + oog + x * 16); } while (0)
    GLA_LOAD(0, 0); GLA_LOAD_DR(0); GLA_LOAD(1, 1);
    for (int n2 = 0; n2 < SEQ / 64; n2 += 2)
#pragma unroll
    for (int par = 0; par < 2; ++par) {
        const int n = n2 + par;
        const size_t t0 = (size_t)b * SEQ + 64 * n;
        __syncthreads();
#pragma unroll
        for (int i = 0; i < 2; ++i) { const int c = tid + 512 * i, row = c >> 4, cc = (c & 15) * 16;
            *(LAS u32x4*)(lds + L_Q + row * QS + cc) = qr[par][i]; *(LAS u32x4*)(lds + L_K + row * QS + cc) = kr[par][i]; }
#pragma unroll
        for (int i = 0; i < 4; ++i) { const int c = tid + 512 * i; *(LAS u32x4*)(lds + L_V + (c >> 5) * VS + (c & 31) * 16) = vr[par][i]; }
        if (tid < 32) {
            const float L2E_ = 1.4426950408889634f;
            *(LAS f32x4*)&dec[tid * 4] = (f32x4){__builtin_amdgcn_exp2f(dr[0] * L2E_), __builtin_amdgcn_exp2f(dr[1] * L2E_), __builtin_amdgcn_exp2f(dr[2] * L2E_), __builtin_amdgcn_exp2f(dr[3] * L2E_)};
        }
        __syncthreads();
        GLA_LOAD_OG(0, n);
#pragma unroll
        for (int i = 0; i < 2; ++i) {
            const int c = tid + 512 * i, row = c >> 4, kc = (c & 15) * 8;
            const f32x4 d0 = *(const LAS f32x4*)&dec[kc], d1 = *(const LAS f32x4*)&dec[kc + 4];
            const u32x4 kv = kr[par][i]; u32x4 ke;
            ke[0] = cvt_pk_bf16(bf_lo(kv[0]) * d0[0], bf_hi(kv[0]) * d0[1]); ke[1] = cvt_pk_bf16(bf_lo(kv[1]) * d0[2], bf_hi(kv[1]) * d0[3]);
            ke[2] = cvt_pk_bf16(bf_lo(kv[2]) * d1[0], bf_hi(kv[2]) * d1[1]); ke[3] = cvt_pk_bf16(bf_lo(kv[3]) * d1[2], bf_hi(kv[3]) * d1[3]);
            *(LAS u32x4*)(lds + L_KE + row * ES + (c & 15) * 16) = ke;
        }
        if (n + 1 < SEQ / 64) GLA_LOAD_DR(n + 1);
        if (n + 2 < SEQ / 64) GLA_LOAD(par, n + 2);
        if (w < 3) {
            const int st = (w == 2) ? 1 : 0, tt = (w == 0) ? 0 : 1;
            f32x16 X;
#pragma unroll
            for (int r = 0; r < 16; ++r) X[r] = 0.f;
#pragma unroll
            for (int ks = 0; ks < 8; ++ks) {
                const bf16x8 ak = *(const LAS bf16x8*)(kb16 + 32 * st * QS + ks * 32);
                const bf16x8 bq2 = *(const LAS bf16x8*)(qb16 + 32 * tt * QS + ks * 32);
                X = __builtin_amdgcn_mfma_f32_32x32x16_bf16(ak, bq2, X, 0, 0, 0);
            }
            if (st == tt) {
#pragma unroll
                for (int r = 0; r < 16; ++r) { const int sr = (r & 3) + 8 * (r >> 2) + 4 * hh; if (sr > j) X[r] = 0.f; }
            }
            *(LAS bf16x8*)(frb + (w * 2 + 0) * 1024) = pack8(X, 0); *(LAS bf16x8*)(frb + (w * 2 + 1) * 1024) = pack8(X, 1);
        }
        f32x16 O[2];
#pragma unroll
        for (int tt = 0; tt < 2; ++tt)
#pragma unroll
            for (int r = 0; r < 16; ++r) O[tt][r] = 0.f;
#pragma unroll
        for (int et = 0; et < 4; ++et)
#pragma unroll
            for (int s2 = 0; s2 < 2; ++s2) {
                const bf16x8 sb = pack8(S[et], s2);
#pragma unroll
                for (int tt = 0; tt < 2; ++tt) {
                    const bf16x8 aq = ld2x64(qb8 + 32 * tt * QS + (32 * et + 16 * s2) * 2);
                    O[tt] = __builtin_amdgcn_mfma_f32_32x32x16_bf16(aq, sb, O[tt], 0, 0, 0);
                }
            }
        __syncthreads();
#pragma unroll
        for (int pr = 0; pr < 3; ++pr) {
            const int st = (pr == 2) ? 1 : 0, tt = (pr == 0) ? 0 : 1;
#pragma unroll
            for (int s2 = 0; s2 < 2; ++s2) {
                const bf16x8 ax = *(const LAS bf16x8*)(frb + (pr * 2 + s2) * 1024);
                const LAS unsigned char* vp = vP + (32 * st + 16 * s2) * VS;
                const bf16x8 bv = tr8(vp, vp + 8 * VS);
                O[tt] = __builtin_amdgcn_mfma_f32_32x32x16_bf16(ax, bv, O[tt], 0, 0, 0);
            }
        }
        __builtin_amdgcn_sched_barrier(0);
#pragma unroll
        for (int tt = 0; tt < 2; ++tt)
#pragma unroll
            for (int r = 0; r < 16; ++r) ob[(32 * tt + (r & 3) + 8 * (r >> 2)) * OS] = O[tt][r];
        __builtin_amdgcn_sched_barrier(0);
#pragma unroll
        for (int et = 0; et < 4; ++et)
#pragma unroll
            for (int rg = 0; rg < 4; ++rg) { const f32x4 dl = *(const LAS f32x4*)&decb[32 * et + 8 * rg];
#pragma unroll
                for (int x = 0; x < 4; ++x) S[et][4 * rg + x] *= dl[x]; }
#pragma unroll
        for (int ks = 0; ks < 4; ++ks) {
            const LAS unsigned char* vp = vN + 16 * ks * VS;
            const bf16x8 bv = tr8(vp, vp + 4 * VS);
#pragma unroll
            for (int et = 0; et < 4; ++et) {
                const LAS unsigned char* kp = keN + 32 * et * 2 + 16 * ks * ES;
                const bf16x8 ak = tr8(kp, kp + 4 * ES);
                S[et] = __builtin_amdgcn_mfma_f32_32x32x16_bf16(ak, bv, S[et], 0, 0, 0);
            }
        }
        __syncthreads();
        {
            const int t = tid >> 3, g8 = tid & 7;
            float ov[32]; float ss = 0.f;
#pragma unroll
            for (int x = 0; x < 8; ++x) { const f32x4 v = *(const LAS f32x4*)&obuf[t * OS + 32 * g8 + 4 * x]; ov[4 * x] = v[0]; ov[4 * x + 1] = v[1]; ov[4 * x + 2] = v[2]; ov[4 * x + 3] = v[3];
                ss += v[0] * v[0] + v[1] * v[1] + v[2] * v[2] + v[3] * v[3]; }
            ss += __builtin_bit_cast(float, __builtin_amdgcn_ds_swizzle(__builtin_bit_cast(int, ss), (1 << 10) | 0x1F)); ss += __builtin_bit_cast(float, __builtin_amdgcn_ds_swizzle(__builtin_bit_cast(int, ss), (2 << 10) | 0x1F));
            ss += __builtin_bit_cast(float, __builtin_amdgcn_ds_swizzle(__builtin_bit_cast(int, ss), (4 << 10) | 0x1F));
            const float rstd = __builtin_amdgcn_rsqf(ss * (1.0f / 256.0f) + EPSV);
            bf16_t* mp = mix + (t0 + t) * DM + 1024 + h * 256 + 32 * g8;
#pragma unroll
            for (int x = 0; x < 4; ++x) {
                const u32x4 og = ogr[x];
                const f32x4 g0 = *(const LAS f32x4*)&gon[32 * g8 + 8 * x], g1 = *(const LAS f32x4*)&gon[32 * g8 + 8 * x + 4];
                const float gg2[8] = {g0[0], g0[1], g0[2], g0[3], g1[0], g1[1], g1[2], g1[3]};
                float res[8];
#pragma unroll
                for (int y = 0; y < 4; ++y) { const float a0 = bf_lo(og[y]), a1 = bf_hi(og[y]);
                    res[2 * y] = ov[8 * x + 2 * y] * rstd * gg2[2 * y] * a0;
                    res[2 * y + 1] = ov[8 * x + 2 * y + 1] * rstd * gg2[2 * y + 1] * a1; }
                u32x4 wv4; wv4[0] = cvt_pk_bf16(res[0], res[1]); wv4[1] = cvt_pk_bf16(res[2], res[3]); wv4[2] = cvt_pk_bf16(res[4], res[5]); wv4[3] = cvt_pk_bf16(res[6], res[7]);
                *(u32x4*)(mp + 8 * x) = wv4;
            }
        }
    }
#undef GLA_LOAD
#undef GLA_LOAD_OG
#undef GLA_LOAD_DR
}
}

__device__ __forceinline__ int moe_idle_wgs(const int* cnt0, const int G) {
    int tiles = 0;
    for (int e = 0; e < NEXP; ++e) tiles += (cnt0[e] + 255) >> 8;
    const int rem = (tiles * 8) % G;
    return rem ? G - rem : 0;
}
constexpr int DEF_RES13 = 2048;
constexpr int DEF_TPB6 = 0, DEF_TPB7 = 0;
__global__ void __launch_bounds__(512, 2) mk_fwd(MkArgs a) {
    extern __shared__ __attribute__((aligned(16))) unsigned char lds_raw[];
    LAS unsigned char* lds = (LAS unsigned char*)lds_raw;
    volatile LAS unsigned* misc = (volatile LAS unsigned*)(lds + LDS_MISC);
    const int wv = __builtin_amdgcn_readfirstlane((int)threadIdx.x >> 6);
    { const int t0_ = mk_tid(wv); if (t0_ < 4) misc[t0_] = 0u; }
    __syncthreads();
    const int lo = a.ph_lo, hi = a.ph_hi;
    unsigned char* ws = a.ws;
    XcdBarrier bar; bar.bar = (unsigned*)(ws + WS_CTL); bar.x = 0; bar.st = misc; bar.wv = wv;
    if (hi - lo > 1) bar = xcd_barrier_post((unsigned*)(ws + WS_CTL), misc, wv);
#define IN(k) (lo <= (k) && (k) < hi)
#define SEAM(k) do { if (IN(k) && IN((k) + 1)) xcd_barrier(bar); } while (0)
    const int G = gridDim.x;
    const int cid = (int)blockIdx.x;
    if (IN(0)) p0_prologue(a, lds, wv);
    SEAM(0);
#define MK_LAYER(l) do { \
        const int pb = 1 + 7 * l; \
        const float* modl = (const float*)(ws + WS_MOD) + (size_t)l * 8 * 6 * DM; \
        if (IN(pb)) { if (l == 0) norm_phase<0>(a, lds, 0, wv); else norm_phase<1>(a, lds, 1, wv); } \
        SEAM(pb); \
        if (IN(pb + 1)) { \
            pg8::DenseOrder S; S.init(NTOK, 6144, DM, (const bf16_t*)(ws + WS_WIN) + (size_t)l * 6144 * DM, G, cid); \
            pg8::EpiInProj E{ws, (float*)(ws + WS_KMEAN) + (size_t)l * 8 * 8 * 8 * 128, (const float*)(ws + WS_ROPE), (const float*)(ws + WS_LA)}; \
            pg8::gemm_phase(lds, (const bf16_t*)(ws + WS_H), DM, S, E, wv); \
        } \
        SEAM(pb + 1); \
        if (IN(pb + 2)) { \
            if (blockIdx.x < 32) gla::gla_unit(lds, ws, a.in[9] + l * 256, (int)blockIdx.x >> 2, (int)blockIdx.x & 3, wv); \
            { int dlo = 0, dhi = DEF_CAP3; \
              if (l == 1) { const int idle = moe_idle_wgs((const int*)(ws + WS_CNT), G); dlo = DEF_CAP3 + idle * (DEF_TPB6 + DEF_TPB7); dhi = NT_DEF - DEF_RES13; dlo = dlo < dhi ? dlo : dhi; } \
              attn::attn_cvt_phase(a, lds, (unsigned*)(ws + WS_CTL + 20480) + l * 64, (unsigned*)(ws + WS_CTL + 20480) + 128 + l * 64, l, dlo, dhi, l == 0 ? 12 : 20, wv); } \
        } \
        SEAM(pb + 2); \
        if (IN(pb + 3)) { \
            pg8::DenseOrder S; S.init(NTOK, DM, DM, (const bf16_t*)(ws + WS_WOUT) + (size_t)l * DM * DM, G, cid); \
            pg8::EpiResGate E{l == 0 ? a.in[0] : (const float*)(ws + WS_X), (float*)(ws + WS_X), modl + 2 * DM}; \
            pg8::gemm_phase(lds, (const bf16_t*)(ws + WS_MIX), DM, S, E, wv); \
        } \
        SEAM(pb + 3); \
        if (IN(pb + 4)) norm_phase<2>(a, lds, l, wv); \
        SEAM(pb + 4); \
        if (IN(pb + 5)) { \
            LAS int* tb = (LAS int*)(lds + 131072 + 1024); \
            pg8::moe_tiles((const int*)(ws + WS_CNT) + l * NEXP, tb, wv); \
            LAS int* rowtab = (LAS int*)(lds + 131072 + 2048); \
            pg8::MoeOrder S{(const int*)(ws + WS_SLOT), (const bf16_t*)(ws + WS_WGU) + (size_t)l * NEXP * 2048 * DM, DM, G, cid, 1, tb, rowtab}; \
            S.fill_rows(mk_tid(wv)); \
            pg8::EpiMoe1 E{rowtab, (bf16_t*)(ws + WS_ACT)}; \
            pg8::gemm_phase(lds, (const bf16_t*)(ws + WS_H), DM, S, E, wv); \
            if (l == 0) cvt_deferred(a, lds, wv, (unsigned*)(ws + WS_CTL + 20480) + 128 + 5 * 64, NT_DEF, NT_DEF + DEF_RES6); \
            else cvt_deferred(a, lds, wv, (unsigned*)(ws + WS_CTL + 20480) + 128 + 4 * 64, NT_DEF - DEF_RES13, NT_DEF); \
        } \
        SEAM(pb + 5); \
        if (IN(pb + 6)) { \
            LAS int* tb = (LAS int*)(lds + 131072 + 1024); \
            pg8::moe_tiles((const int*)(ws + WS_CNT) + l * NEXP, tb, wv); \
            LAS int* rowtab = (LAS int*)(lds + 131072 + 2048); \
            pg8::MoeOrder S{(const int*)(ws + WS_SLOT), (const bf16_t*)(ws + WS_WD) + (size_t)l * NEXP * DM * DEXP, DEXP, G, cid, 0, tb, rowtab}; \
            S.fill_rows(mk_tid(wv)); \
            pg8::EpiMoe2 E{rowtab, (bf16_t*)(ws + WS_YB)}; \
            pg8::gemm_phase(lds, (const bf16_t*)(ws + WS_ACT), DEXP, S, E, wv); \
            if (l == 0) cvt_deferred(a, lds, wv, (unsigned*)(ws + WS_CTL + 20480) + 128 + 6 * 64, NT_DEF + DEF_RES6, NT_DEF + DEF_RES6 + DEF_RES7); \
        } \
        SEAM(pb + 6); \
    } while (0)
    MK_LAYER(0);
    MK_LAYER(1);
#undef MK_LAYER
    if (IN(15)) norm_phase<3>(a, lds, 1, wv);
#undef IN
#undef SEAM
}

static void mk_launch(const MkArgs& base, int lo, int hi, hipStream_t stream) {
    static bool attr = false;
    if (!attr) { (void)hipFuncSetAttribute((const void*)mk_fwd, hipFuncAttributeMaxDynamicSharedMemorySize, LDS_BYTES); attr = true; }
    MkArgs a = base; a.ph_lo = lo; a.ph_hi = hi;
    hipLaunchKernelGGL(mk_fwd, dim3(256), dim3(512), LDS_BYTES, stream, a);
}

extern "C" void kernel_launch(void* const* d_in, const int* in_sizes, int n_in, void* d_out, int out_size, void* d_ws, size_t ws_size, hipStream_t stream) {
    MkArgs base{};
    for (int i = 0; i < 19; ++i) base.in[i] = (const float*)d_in[i];
    base.out = (float*)d_out; base.ws = (unsigned char*)d_ws;
    (void)hipMemsetAsync((unsigned char*)d_ws + WS_CTL, 0, CTL_BYTES, stream);
    mk_launch(base, 0, NPHASE, stream);
}
```

```cpp
#include <hip/hip_runtime.h>
#include <stdint.h>

#define DM 2048
#define NBATCH 8
#define SEQ 2048
#define NTOK (NBATCH * SEQ)
#define INW 6160
#define OFF_GA 6144
#define NEXP 32
#define DEXP 1024
#define ECAP 16384
#define EPSV 1e-6f


#define LAS __attribute__((address_space(3)))
typedef unsigned short bf16_t;
typedef short bf16x8 __attribute__((ext_vector_type(8)));
typedef float f32x4 __attribute__((ext_vector_type(4)));
typedef unsigned u32x4 __attribute__((ext_vector_type(4)));
typedef unsigned u32x2 __attribute__((ext_vector_type(2)));

#define ATTN_SCALE_F 0.08838834764831845f
#define QSCALE (ATTN_SCALE_F * 1.4426950408889634f)

typedef float f32x2_t __attribute__((ext_vector_type(2)));
typedef __bf16 bf16x2_t __attribute__((ext_vector_type(2)));
__device__ __forceinline__ unsigned cvt_pk_bf16(float lo, float hi) { const bf16x2_t r = __builtin_convertvector((f32x2_t){lo, hi}, bf16x2_t); return __builtin_bit_cast(unsigned, r); }
__device__ __forceinline__ float silu_fast(float x) { return x * __builtin_amdgcn_rcpf(1.0f + __builtin_amdgcn_exp2f(-x * 1.4426950408889634f)); }
__device__ __forceinline__ float bf_lo(unsigned w) { return __uint_as_float(w << 16); }
__device__ __forceinline__ float bf_hi(unsigned w) { return __uint_as_float(w & 0xffff0000u); }

__device__ __forceinline__ int mk_tid(const int wv) { int ln; asm volatile("v_mbcnt_lo_u32_b32 %0, -1, 0\n\tv_mbcnt_hi_u32_b32 %0, -1, %0" : "=v"(ln)); return wv * 64 + ln; }

constexpr size_t AL(size_t x) { return (x + 255) & ~(size_t)255; }
constexpr size_t WS_CTL = 0;
constexpr size_t CTL_BYTES = 32768;
constexpr size_t WS_CNT = WS_CTL + 16384;
constexpr size_t WS_MOD = AL(WS_CTL + CTL_BYTES);
constexpr size_t WS_ROPE = AL(WS_MOD + (size_t)2 * 8 * 6 * DM * 4);
constexpr size_t WS_KMEAN = AL(WS_ROPE + (size_t)SEQ * 32 * 4);
constexpr size_t WS_WIN = AL(WS_KMEAN + (size_t)2 * 8 * 8 * 8 * 128 * 4);
constexpr size_t WS_WOUT = AL(WS_WIN + (size_t)2 * 6144 * DM * 2);
constexpr size_t WS_WGU = AL(WS_WOUT + (size_t)2 * DM * DM * 2);
constexpr size_t WS_WD = AL(WS_WGU + (size_t)2 * NEXP * 2048 * DM * 2);
constexpr size_t WS_X = AL(WS_WD + (size_t)2 * NEXP * DM * DEXP * 2);
constexpr size_t WS_H = AL(WS_X + (size_t)NTOK * DM * 4);
constexpr size_t WS_Q = AL(WS_H + (size_t)NTOK * DM * 2);
constexpr size_t WS_K = AL(WS_Q + (size_t)NTOK * 1024 * 2);
constexpr size_t WS_VT = AL(WS_K + (size_t)NTOK * 1024 * 2);
constexpr size_t WS_QG = AL(WS_VT + (size_t)NTOK * 1024 * 2);
constexpr size_t WS_KG = AL(WS_QG + (size_t)NTOK * 512 * 2);
constexpr size_t WS_VG = AL(WS_KG + (size_t)NTOK * 512 * 2);
constexpr size_t WS_OG = AL(WS_VG + (size_t)NTOK * 1024 * 2);
constexpr size_t WS_LA = AL(WS_OG + (size_t)NTOK * 1024 * 2);
constexpr size_t WS_MIX = AL(WS_LA + (size_t)NTOK * 512 * 4);
constexpr size_t WS_ACT = AL(WS_MIX + (size_t)NTOK * DM * 2);
constexpr size_t WS_YB = AL(WS_ACT + (size_t)2 * NTOK * DEXP * 2);
constexpr size_t WS_SLOT = AL(WS_YB + (size_t)2 * NTOK * DM * 2);
constexpr size_t WS_TOKW = AL(WS_SLOT + (size_t)NEXP * ECAP * 4);
constexpr size_t WS_WRF = AL(WS_TOKW + (size_t)NTOK * 2 * 4);
constexpr size_t WS_WGAF = AL(WS_WRF + (size_t)2 * 64 * 3 * 2 * 64 * 16);
constexpr size_t WS_KE = AL(WS_WGAF + (size_t)2 * 64 * 2 * 64 * 16);
constexpr size_t WS_FAST_END = AL(WS_KE + (size_t)NTOK * 512 * 2);

constexpr int LDS_BYTES = 163840;
constexpr int LDS_MISC = 163840 - 64;
constexpr int NPHASE = 16;

struct MkArgs {
    const float* in[19]; float* out; unsigned char* ws; int ph_lo, ph_hi;
};

#define XB_TMO      128
#define XB_XCNT(j)  (256  + 64 * (j))
#define XB_XSUB(j)  (1280 + 64 * (j))
#define XB_XGEN(j)  (2304 + 64 * (j))
#define XB_TOP      3328
#define XB_TOPGEN   3392
#define XCD_BAR_WORDS 3456
#define XB_SPIN_CAP (1u << 18)
__device__ __forceinline__ unsigned xb_ld(unsigned* p)              { return __hip_atomic_load(p, __ATOMIC_RELAXED, __HIP_MEMORY_SCOPE_AGENT); }
__device__ __forceinline__ unsigned xb_add(unsigned* p, unsigned v) { return __hip_atomic_fetch_add(p, v, __ATOMIC_RELAXED, __HIP_MEMORY_SCOPE_AGENT); }
__device__ __forceinline__ unsigned xb_xcc_id() { return (unsigned)__builtin_amdgcn_s_getreg((3 << 11) | 20) & 0xFu; }
#define XB_SPIN(cond, bar) do { unsigned _sp = 0; while (cond) { __builtin_amdgcn_s_sleep(1); \
    if ((++_sp & 255u) == 0u) { if (xb_ld(&(bar)[XB_TMO])) break; if (_sp > XB_SPIN_CAP) { atomicAdd(&(bar)[XB_TMO], 1u); break; } } } } while (0)
struct XcdBarrier { unsigned* bar; unsigned x; volatile LAS unsigned* st; int wv; };
__device__ __forceinline__ XcdBarrier xcd_barrier_post(unsigned* bar, volatile LAS unsigned* st, const int wv) {
    XcdBarrier b; b.bar = bar; b.x = xb_xcc_id(); b.st = st; b.wv = wv;
    if (mk_tid(wv) == 0) (void)xb_add(&bar[XB_XCNT(b.x)], 1u);
    return b;
}
__device__ __forceinline__ void xcd_barrier_complete(unsigned* bar, unsigned x, unsigned& nloc, unsigned& nx) {
    const unsigned G = gridDim.x * gridDim.y * gridDim.z;
    unsigned sum, cnt, mine, sp = 0u;
    for (;;) {
        sum = 0u; cnt = 0u; mine = 0u;
#pragma unroll
        for (unsigned j = 0; j < 16; ++j) { const unsigned c = xb_ld(&bar[XB_XCNT(j)]); sum += c; cnt += (c > 0u) ? 1u : 0u; mine = (j == x) ? c : mine; }
        if (sum == G) break;
        __builtin_amdgcn_s_sleep(1);
        if ((++sp & 255u) == 0u) { if (xb_ld(&bar[XB_TMO])) break; if (sp > XB_SPIN_CAP) { atomicAdd(&bar[XB_TMO], 1u); break; } }
    }
    nloc = mine > 0u ? mine : 1u; nx = cnt > 0u ? cnt : 1u;
}
__device__ __forceinline__ void xcd_barrier(const XcdBarrier& b) {
    asm volatile("s_waitcnt vmcnt(0)" ::: "memory");
    __syncthreads();
    if (mk_tid(b.wv) == 0) {
        unsigned* bar = b.bar;
        __builtin_amdgcn_s_waitcnt(0);
        unsigned nloc = b.st[0], nx = b.st[1];
        if (nloc == 0u) { xcd_barrier_complete(bar, b.x, nloc, nx); b.st[0] = nloc; b.st[1] = nx; }
        const unsigned old = xb_add(&bar[XB_XSUB(b.x)], 1u);
        const unsigned gen = old / nloc;
        if (old + 1u == (gen + 1u) * nloc) {
            __builtin_amdgcn_fence(__ATOMIC_RELEASE, "agent");
            asm volatile("s_waitcnt vmcnt(0)" ::: "memory");
            const unsigned og = xb_add(&bar[XB_TOP], 1u);
            const unsigned tg = og / nx;
            if (og + 1u == (tg + 1u) * nx) xb_add(&bar[XB_TOPGEN], 1u);
            else XB_SPIN(xb_ld(&bar[XB_TOPGEN]) == tg, bar);
            __builtin_amdgcn_fence(__ATOMIC_ACQUIRE, "agent");
            xb_add(&bar[XB_XGEN(b.x)], 1u);
            asm volatile("s_waitcnt vmcnt(0)" ::: "memory");
        } else {
            XB_SPIN(xb_ld(&bar[XB_XGEN(b.x)]) == gen, bar);
            __builtin_amdgcn_fence(__ATOMIC_ACQUIRE, "agent");
            asm volatile("s_waitcnt vmcnt(0)" ::: "memory");
        }
    }
    __syncthreads();
}

constexpr int NT_IN = 2 * 16 * 48, NT_OUT = 2 * 16 * 16, NT_G = 64 * 16 * 8, NT_D = 64 * 8 * 16;
constexpr int NT_ALL = NT_IN + NT_OUT + 2 * NT_G + NT_D;
__device__ __forceinline__ void cvt_decode(int t, const float* w_in, const float* w_out, const float* w_eg, const float* w_eu, const float* w_ed,
                                           bf16_t* WinT, bf16_t* WoutT, bf16_t* WguT, bf16_t* WdT, const float*& s_, bf16_t*& d_, int& ld_, int& K_) {
    if (t < 2 * NT_G) { const int which = t / NT_G, t3 = t % NT_G, le = t3 / 128, r = t3 % 128, kt = r / 8, nt = r % 8;
        s_ = (which ? w_eu : w_eg) + (size_t)le * DM * DEXP + (size_t)kt * 128 * DEXP + nt * 128; ld_ = DEXP; K_ = DM;
        d_ = WguT + (size_t)le * 2048 * DM + (size_t)(nt * 256 + which * 128) * DM + kt * 128; }
    else if (t < 2 * NT_G + NT_D) { const int t2 = t - 2 * NT_G, le = t2 / 128, r = t2 % 128, kt = r / 16, nt = r % 16;
        s_ = w_ed + (size_t)le * DEXP * DM + (size_t)kt * 128 * DM + nt * 128; ld_ = DM; K_ = DEXP; d_ = WdT + (size_t)le * DM * DEXP + (size_t)nt * 128 * DEXP + kt * 128; }
    else if (t < 2 * NT_G + NT_D + NT_OUT) { const int t2 = t - 2 * NT_G - NT_D, l = 1 - t2 / 256, r = t2 % 256, kt = r / 16, nt = r % 16;
        s_ = w_out + (size_t)l * DM * DM + (size_t)kt * 128 * DM + nt * 128; ld_ = DM; K_ = DM; d_ = WoutT + (size_t)l * DM * DM + (size_t)nt * 128 * DM + kt * 128; }
    else { const int t2 = t - 2 * NT_G - NT_D - NT_OUT, l = 1 - t2 / (16 * 48), r = t2 % (16 * 48), kt = r / 48, nt = r % 48;
        s_ = w_in + (size_t)l * DM * INW + (size_t)kt * 128 * INW + nt * 128; ld_ = INW; K_ = DM; d_ = WinT + (size_t)l * 6144 * DM + (size_t)nt * 128 * DM + kt * 128; }
}
constexpr int DEF_RES6 = 2048;
constexpr int DEF_RES7 = 768 + 256;
constexpr int NT_PRO = 3 * 4096 - DEF_RES6 + 256 + 768, NT_DEF = 3 * 4096, DEF_CAP3 = 5184;
__device__ __forceinline__ int cvt_map(int i, bool deferred) {
    if (deferred) {
        if (i >= NT_DEF) { const int j = i - NT_DEF; if (j < DEF_RES6) return 16384 + 4096 - DEF_RES6 + j;
            const int r = j - DEF_RES6; return r < 768 ? 24576 + 512 + r : 24576 + (r - 768); }
        return i < 4096 ? 4096 + i : (i < 8192 ? i + 8192 : i + 12288); }
    if (i < 12288 - DEF_RES6) return i < 4096 ? i : (i < 8192 ? i + 4096 : i + 8192);
    const int k = i - (12288 - DEF_RES6);
    return k < 256 ? 24576 + 256 + k : 24576 + 1280 + (k - 256);
}
__device__ __forceinline__ void cvt_range(const MkArgs& a, LAS unsigned char* lds, const int tid, const int first, const int step, const int end, const bool deferred) {
    unsigned char* ws = a.ws;
    constexpr int RS = 320;
    const float* w_in = a.in[6]; const float* w_out = a.in[10]; const float* w_eg = a.in[15]; const float* w_eu = a.in[16]; const float* w_ed = a.in[17];
    bf16_t* WinT = (bf16_t*)(ws + WS_WIN); bf16_t* WoutT = (bf16_t*)(ws + WS_WOUT); bf16_t* WguT = (bf16_t*)(ws + WS_WGU); bf16_t* WdT = (bf16_t*)(ws + WS_WD);
    const int kk = tid >> 5, c4 = tid & 31;
    f32x4 v[8], vn[8], vm[8];
    const float* src = nullptr; bf16_t* dst = nullptr; int ld = 0, K = 0;
    const float* srcn = nullptr; bf16_t* dstn = nullptr; int ldn = 0, Kn = 0;
    int t = first;
    if (t < end) { cvt_decode(cvt_map(t, deferred), w_in, w_out, w_eg, w_eu, w_ed, WinT, WoutT, WguT, WdT, src, dst, ld, K);
#pragma unroll
        for (int i = 0; i < 8; ++i) v[i] = __builtin_nontemporal_load((const f32x4*)(src + (size_t)(kk + 16 * i) * ld + c4 * 4)); }
    if (t + step < end) { cvt_decode(cvt_map(t + step, deferred), w_in, w_out, w_eg, w_eu, w_ed, WinT, WoutT, WguT, WdT, srcn, dstn, ldn, Kn);
#pragma unroll
        for (int i = 0; i < 8; ++i) vn[i] = __builtin_nontemporal_load((const f32x4*)(srcn + (size_t)(kk + 16 * i) * ldn + c4 * 4)); }
    while (t < end) {
        const int tm = t + 2 * step; const float* srcm = nullptr; bf16_t* dstm = nullptr; int ldm = 0, Km = 0;
        if (tm < end) { cvt_decode(cvt_map(tm, deferred), w_in, w_out, w_eg, w_eu, w_ed, WinT, WoutT, WguT, WdT, srcm, dstm, ldm, Km);
#pragma unroll
            for (int i = 0; i < 8; ++i) vm[i] = __builtin_nontemporal_load((const f32x4*)(srcm + (size_t)(kk + 16 * i) * ldm + c4 * 4)); }
#pragma unroll
        for (int i = 0; i < 8; ++i) {
            u32x2 p; p[0] = cvt_pk_bf16(v[i][0], v[i][1]); p[1] = cvt_pk_bf16(v[i][2], v[i][3]);
            *(LAS u32x2*)(lds + (kk + 16 * i) * RS + c4 * 8) = p;
        }
        __syncthreads();
        {
            typedef short s16x4_t __attribute__((ext_vector_type(4)));
            const int ln = tid & 63, wq = tid >> 6, li = ln & 15, gq = li >> 2, gp = li & 3, G4 = ln >> 4;
#pragma unroll
            for (int i = 0; i < 4; ++i) {
                const int nb = wq, k8 = 2 * (G4 + 4 * (i >> 1)) + (i & 1);
                const LAS unsigned char* p0 = lds + (8 * k8 + gq) * RS + (16 * nb + 4 * gp) * 2;
                const s16x4_t x0 = __builtin_amdgcn_ds_read_tr16_b64_v4i16((LAS s16x4_t*)p0), x1 = __builtin_amdgcn_ds_read_tr16_b64_v4i16((LAS s16x4_t*)(p0 + 4 * RS));
                typedef short s16x8_t __attribute__((ext_vector_type(8)));
                const s16x8_t o8 = (s16x8_t){x0[0], x0[1], x0[2], x0[3], x1[0], x1[1], x1[2], x1[3]};
                *(u32x4*)(dst + (size_t)(16 * nb + li) * K + k8 * 8) = __builtin_bit_cast(u32x4, o8);
            }
        }
        __syncthreads();
        t += step; src = srcn; dst = dstn; ld = ldn; K = Kn; srcn = srcm; dstn = dstm; ldn = ldm; Kn = Km;
#pragma unroll
        for (int i = 0; i < 8; ++i) { v[i] = vn[i]; vn[i] = vm[i]; }
    }
}
__device__ __forceinline__ void cvt_deferred(const MkArgs& a, LAS unsigned char* lds, const int wv, unsigned* queue, const int lo, const int hi) {
    int tid = mk_tid(wv); asm volatile("" : "+v"(tid));
    LAS int* slot = (LAS int*)(lds + 49152);
    for (;;) {
        __syncthreads();
        if (tid == 0) *slot = lo + (int)atomicAdd(queue, 4u);
        __syncthreads();
        const int base = *slot;
        if (base >= hi) break;
        cvt_range(a, lds, tid, base, 1, (base + 4 < hi) ? base + 4 : hi, true);
    }
}
__device__ __forceinline__ void p0_prologue(const MkArgs& a, LAS unsigned char* lds, const int wv) {
    int tid = mk_tid(wv); asm volatile("" : "+v"(tid));
    const int G = gridDim.x, bx = blockIdx.x;
    unsigned char* ws = a.ws;
    {
        float* rope = (float*)(ws + WS_ROPE);
        for (int idx = bx * 512 + tid; idx < SEQ * 16; idx += G * 512) {
            const int pos = idx >> 4, i = idx & 15;
            const float inv = powf(500000.0f, -(float)i * (2.0f / 32.0f));
            const float ang = (float)pos * inv;
            rope[pos * 32 + i] = cosf(ang); rope[pos * 32 + 16 + i] = sinf(ang);
        }
        float* km = (float*)(ws + WS_KMEAN);
        for (int idx = bx * 512 + tid; idx < 2 * 8 * 8 * 8 * 128; idx += G * 512) km[idx] = 0.f;
    }
    {
        u32x4* wrf = (u32x4*)(ws + WS_WRF); u32x4* wgaf = (u32x4*)(ws + WS_WGAF);
        for (int idx = bx * 512 + tid; idx < 2 * 64 * 4 * 64; idx += G * 512) {
            const int ln = idx & 63, nt = (idx >> 6) & 3, ks = (idx >> 8) & 63, l = idx >> 14;
            const int n = 16 * nt + (ln & 15), k0 = 32 * ks + 8 * (ln >> 4);
            float v[8];
#pragma unroll
            for (int j = 0; j < 8; ++j) {
                const int k = k0 + j;
                if (nt == 3) v[j] = a.in[6][((size_t)l * DM + k) * INW + OFF_GA + (ln & 15)];
                else v[j] = n < 4 ? a.in[11][((size_t)l * DM + k) * 4 + n] : (n < 36 ? a.in[13][((size_t)l * DM + k) * 32 + n - 4] : 0.f);
            }
            u32x4 hi, lo;
#pragma unroll
            for (int e = 0; e < 4; ++e) { const unsigned hp = cvt_pk_bf16(v[2 * e], v[2 * e + 1]); hi[e] = hp; lo[e] = cvt_pk_bf16(v[2 * e] - bf_lo(hp), v[2 * e + 1] - bf_hi(hp)); }
            if (nt == 3) { wgaf[(((size_t)l * 64 + ks) * 2 + 0) * 64 + ln] = hi; wgaf[(((size_t)l * 64 + ks) * 2 + 1) * 64 + ln] = lo; }
            else { wrf[((((size_t)l * 64 + ks) * 3 + nt) * 2 + 0) * 64 + ln] = hi; wrf[((((size_t)l * 64 + ks) * 3 + nt) * 2 + 1) * 64 + ln] = lo; }
        }
    }
    {
        LAS float* cact = (LAS float*)lds;
        LAS float* red = (LAS float*)(lds + 65536);
        const float* c = a.in[1]; const float* w_ada = a.in[4]; const float* b_ada = a.in[5];
        float* mod = (float*)(ws + WS_MOD);
        for (int i = tid; i < NBATCH * DM; i += 512) { const float v = c[i]; cact[i] = v / (1.0f + expf(-v)); }
        __syncthreads();
        for (int cb = bx; cb < 256; cb += G) {
            const int l = cb >> 7, j0 = (cb & 127) * 96;
            if (tid < 384) {
                const int cg = tid % 24, ks = tid / 24;
                f32x4 acc[8];
#pragma unroll
                for (int b = 0; b < 8; ++b) acc[b] = (f32x4){0.f, 0.f, 0.f, 0.f};
                const float* wp = w_ada + ((size_t)l * DM + ks * 128) * (6 * DM) + j0 + cg * 4;
#pragma unroll 8
                for (int k = 0; k < 128; ++k) {
                    const f32x4 w = *(const f32x4*)(wp + (size_t)k * (6 * DM));
#pragma unroll
                    for (int b = 0; b < 8; ++b) acc[b] += cact[b * DM + ks * 128 + k] * w;
                }
#pragma unroll
                for (int b = 0; b < 8; ++b) *(LAS f32x4*)&red[(ks * 8 + b) * 96 + cg * 4] = acc[b];
            }
            __syncthreads();
            for (int o = tid; o < 768; o += 512) {
                const int b = o / 96, j = o % 96; float s = 0.f;
#pragma unroll
                for (int ks = 0; ks < 16; ++ks) s += red[(ks * 8 + b) * 96 + j];
                mod[((size_t)l * 8 + b) * (6 * DM) + j0 + j] = s + b_ada[l * 6 * DM + j0 + j];
            }
            __syncthreads();
        }
    }
    cvt_range(a, lds, tid, bx, G, NT_PRO, false);
}

template <int MODE>
__device__ __forceinline__ void norm_phase(const MkArgs& a, LAS unsigned char* lds, const int l, const int wv) {
    int tid = mk_tid(wv); asm volatile("" : "+v"(tid));
    const int G = gridDim.x, bx = blockIdx.x;
    const int w = __builtin_amdgcn_readfirstlane(tid >> 6), lane = tid & 63, r = lane & 15, q = lane >> 4;
    unsigned char* ws = a.ws;
    float* xcur = (float*)(ws + WS_X);
    bf16_t* hb = (bf16_t*)(ws + WS_H);
    const float* mod = (const float*)(ws + WS_MOD);
    LAS float* ssp = (LAS float*)lds;
    LAS float* part = (LAS float*)(lds + 1024);
    LAS float* lgt = (LAS float*)(lds + 1024 + 8 * 16 * 48 * 4);
    LAS int* rexp = (LAS int*)(lds + 28672);
    LAS int* lcnt = (LAS int*)(lds + 28672 + 512);
    LAS int* lbase = (LAS int*)(lds + 28672 + 640);
    LAS float* tabA = (LAS float*)(lds + 73728);
    LAS float* tabB = (LAS float*)(lds + 81920);
    LAS float* tabG = (LAS float*)(lds + 90112);
    if (MODE == 2 && tid < 32) lcnt[tid] = 0;
    const float* gain = (MODE == 3) ? a.in[18] : (MODE == 2 ? a.in[3] + l * DM : a.in[2] + l * DM);
    float carry = 0.f;
    for (int cb4 = bx * 4; cb4 < NTOK / 16; cb4 += G * 4)
    for (int rb = cb4; rb < cb4 + 4; ++rb) {
        const int t = rb * 16 + r, b = (rb * 16) / SEQ;
        const float* xsrc = (MODE == 0) ? a.in[0] : xcur;
        if (rb == cb4) {
            const int k4 = tid * 4;
            const f32x4 g4 = *(const f32x4*)(gain + k4);
            if constexpr (MODE != 3) {
                const float* sh_ = mod + ((size_t)l * 8 + b) * (6 * DM) + (MODE == 2 ? 3 * DM : 0);
                const f32x4 s4 = *(const f32x4*)(sh_ + k4), c4 = *(const f32x4*)(sh_ + DM + k4);
                *(LAS f32x4*)&tabA[k4] = (f32x4){g4[0] * (1.0f + c4[0]), g4[1] * (1.0f + c4[1]), g4[2] * (1.0f + c4[2]), g4[3] * (1.0f + c4[3])};
                *(LAS f32x4*)&tabB[k4] = s4;
            } else *(LAS f32x4*)&tabA[k4] = g4;
            if constexpr (MODE == 1 || MODE == 3) {
                const int lm_ = (MODE == 1) ? l - 1 : 1;
                *(LAS f32x4*)&tabG[k4] = *(const f32x4*)(mod + ((size_t)lm_ * 8 + b) * (6 * DM) + 5 * DM + k4);
            }
            __syncthreads();
        }
        float xv[64];
#pragma unroll
        for (int j = 0; j < 8; ++j) {
            const int k = 256 * w + 32 * j + 8 * q;
            const f32x4 v0 = *(const f32x4*)(xsrc + (size_t)t * DM + k), v1 = *(const f32x4*)(xsrc + (size_t)t * DM + k + 4);
            xv[8 * j + 0] = v0[0]; xv[8 * j + 1] = v0[1]; xv[8 * j + 2] = v0[2]; xv[8 * j + 3] = v0[3];
            xv[8 * j + 4] = v1[0]; xv[8 * j + 5] = v1[1]; xv[8 * j + 6] = v1[2]; xv[8 * j + 7] = v1[3];
        }
        if constexpr (MODE == 1 || MODE == 3) {
            const float* tokw = (const float*)(ws + WS_TOKW);
            const bf16_t* yb = (const bf16_t*)(ws + WS_YB);
            const float w0 = tokw[2 * t], w1 = tokw[2 * t + 1];
#pragma unroll
            for (int j = 0; j < 8; ++j) {
                const int k = 256 * w + 32 * j + 8 * q;
                const u32x4 y0 = *(const u32x4*)(yb + (size_t)(2 * t) * DM + k), y1 = *(const u32x4*)(yb + (size_t)(2 * t + 1) * DM + k);
                const f32x4 g0 = *(const LAS f32x4*)&tabG[k], g1 = *(const LAS f32x4*)&tabG[k + 4];
                xv[8 * j + 0] += g0[0] * (w0 * bf_lo(y0[0]) + w1 * bf_lo(y1[0])); xv[8 * j + 1] += g0[1] * (w0 * bf_hi(y0[0]) + w1 * bf_hi(y1[0]));
                xv[8 * j + 2] += g0[2] * (w0 * bf_lo(y0[1]) + w1 * bf_lo(y1[1])); xv[8 * j + 3] += g0[3] * (w0 * bf_hi(y0[1]) + w1 * bf_hi(y1[1]));
                xv[8 * j + 4] += g1[0] * (w0 * bf_lo(y0[2]) + w1 * bf_lo(y1[2])); xv[8 * j + 5] += g1[1] * (w0 * bf_hi(y0[2]) + w1 * bf_hi(y1[2]));
                xv[8 * j + 6] += g1[2] * (w0 * bf_lo(y0[3]) + w1 * bf_lo(y1[3])); xv[8 * j + 7] += g1[3] * (w0 * bf_hi(y0[3]) + w1 * bf_hi(y1[3]));
                if constexpr (MODE == 1) {
                    *(f32x4*)(xcur + (size_t)t * DM + k) = (f32x4){xv[8 * j + 0], xv[8 * j + 1], xv[8 * j + 2], xv[8 * j + 3]};
                    *(f32x4*)(xcur + (size_t)t * DM + k + 4) = (f32x4){xv[8 * j + 4], xv[8 * j + 5], xv[8 * j + 6], xv[8 * j + 7]};
                }
            }
        }
        float ss = 0.f;
#pragma unroll
        for (int i = 0; i < 64; ++i) ss += xv[i] * xv[i];
        ss += __shfl_xor(ss, 16); ss += __shfl_xor(ss, 32);
        if (q == 0) ssp[w * 16 + r] = ss;
        __syncthreads();
        float tot = 0.f;
#pragma unroll
        for (int i = 0; i < 8; ++i) tot += ssp[i * 16 + r];
        const float rstd = 1.0f / sqrtf(tot * (1.0f / DM) + EPSV);
#pragma unroll
        for (int j = 0; j < 8; ++j) {
            const int k = 256 * w + 32 * j + 8 * q;
            const f32x4 g0 = *(const LAS f32x4*)&tabA[k], g1 = *(const LAS f32x4*)&tabA[k + 4];
            float gg[8] = {g0[0], g0[1], g0[2], g0[3], g1[0], g1[1], g1[2], g1[3]};
            if constexpr (MODE != 3) {
                const f32x4 s0 = *(const LAS f32x4*)&tabB[k], s1 = *(const LAS f32x4*)&tabB[k + 4];
                const float sv[8] = {s0[0], s0[1], s0[2], s0[3], s1[0], s1[1], s1[2], s1[3]};
#pragma unroll
                for (int i = 0; i < 8; ++i) xv[8 * j + i] = (xv[8 * j + i] * rstd) * gg[i] + sv[i];
                u32x4 o; o[0] = cvt_pk_bf16(xv[8 * j + 0], xv[8 * j + 1]); o[1] = cvt_pk_bf16(xv[8 * j + 2], xv[8 * j + 3]);
                o[2] = cvt_pk_bf16(xv[8 * j + 4], xv[8 * j + 5]); o[3] = cvt_pk_bf16(xv[8 * j + 6], xv[8 * j + 7]);
                *(u32x4*)(hb + (size_t)t * DM + k) = o;
            } else {
#pragma unroll
                for (int i = 0; i < 8; ++i) xv[8 * j + i] = xv[8 * j + i] * rstd * gg[i];
                *(f32x4*)(a.out + (size_t)t * DM + k) = (f32x4){xv[8 * j + 0], xv[8 * j + 1], xv[8 * j + 2], xv[8 * j + 3]};
                *(f32x4*)(a.out + (size_t)t * DM + k + 4) = (f32x4){xv[8 * j + 4], xv[8 * j + 5], xv[8 * j + 6], xv[8 * j + 7]};
            }
        }
        if constexpr (MODE == 0 || MODE == 1) {
            const char* wb = (const char*)(ws + WS_WGAF) + ((size_t)l * 64 + w * 8) * 2 * 1024;
            unsigned lo16 = (unsigned)lane * 16u; asm volatile("" : "+v"(lo16));
#define WFRAG(i) (*(const u32x4*)(wb + (i) * 1024 + lo16))
            f32x4 acc = (f32x4){0.f, 0.f, 0.f, 0.f};
            u32x4 fr[16];
#pragma unroll
            for (int i = 0; i < 16; ++i) fr[i] = WFRAG(i);
#pragma unroll
            for (int j = 0; j < 8; ++j) {
                u32x4 ah, al;
#pragma unroll
                for (int e = 0; e < 4; ++e) { const unsigned hp = cvt_pk_bf16(xv[8 * j + 2 * e], xv[8 * j + 2 * e + 1]); ah[e] = hp;
                    al[e] = cvt_pk_bf16(xv[8 * j + 2 * e] - bf_lo(hp), xv[8 * j + 2 * e + 1] - bf_hi(hp)); }
                const u32x4 bh = fr[2 * j], bl = fr[2 * j + 1];
                acc = __builtin_amdgcn_mfma_f32_16x16x32_bf16(__builtin_bit_cast(bf16x8, ah), __builtin_bit_cast(bf16x8, bh), acc, 0, 0, 0);
                acc = __builtin_amdgcn_mfma_f32_16x16x32_bf16(__builtin_bit_cast(bf16x8, ah), __builtin_bit_cast(bf16x8, bl), acc, 0, 0, 0);
                acc = __builtin_amdgcn_mfma_f32_16x16x32_bf16(__builtin_bit_cast(bf16x8, al), __builtin_bit_cast(bf16x8, bh), acc, 0, 0, 0);
            }
#pragma unroll
            for (int e = 0; e < 4; ++e) part[(w * 16 + 4 * q + e) * 48 + r] = acc[e];
#undef WFRAG
            __syncthreads();
            {
                const float* w_gk = a.in[7] + (size_t)l * 16 * 512; const float* b_gk = a.in[8] + l * 512;
                float wr[16];
#pragma unroll
                for (int c = 0; c < 16; ++c) wr[c] = w_gk[c * 512 + tid];
                const float bz = b_gk[tid];
                LAS float* gs = (LAS float*)(lds + 32768);
                if (tid < 256) {
                    const int rr = tid >> 4, c = tid & 15; float s = 0.f;
#pragma unroll
                    for (int i = 0; i < 8; ++i) s += part[(i * 16 + rr) * 48 + c];
                    gs[tid] = s;
                }
                __syncthreads();
                float* bc = (float*)(ws + WS_LA);
                if ((rb & 3) == 0) carry = 0.f;
#pragma unroll
                for (int rr = 0; rr < 16; ++rr) {
                    const f32x4 g0 = *(const LAS f32x4*)&gs[rr * 16], g1 = *(const LAS f32x4*)&gs[rr * 16 + 4], g2 = *(const LAS f32x4*)&gs[rr * 16 + 8], g3 = *(const LAS f32x4*)&gs[rr * 16 + 12];
                    float z = bz;
#pragma unroll
                    for (int c = 0; c < 4; ++c) z += g0[c] * wr[c] + g1[c] * wr[4 + c] + g2[c] * wr[8 + c] + g3[c] * wr[12 + c];
                    const float ls = fminf(z, 0.f) - 0.6931471805599453f * __builtin_amdgcn_logf(1.0f + __builtin_amdgcn_exp2f(-fabsf(z) * 1.4426950408889634f));
                    carry += ls * (1.0f / 16.0f);
                    bc[(size_t)(rb * 16 + rr) * 512 + tid] = carry;
                }
            }
        }
        if constexpr (MODE == 2) {
            const char* wb = (const char*)(ws + WS_WRF) + ((size_t)l * 64 + w * 8) * 6 * 1024;
            unsigned lo16 = (unsigned)lane * 16u; asm volatile("" : "+v"(lo16));
#define WFRAG(i) (*(const u32x4*)(wb + (i) * 1024 + lo16))
            f32x4 acc[3];
#pragma unroll
            for (int nt = 0; nt < 3; ++nt) acc[nt] = (f32x4){0.f, 0.f, 0.f, 0.f};
            u32x4 frA[16], frB[16];
#define RT_LOAD(fr, c) do { _Pragma("unroll") for (int i = 0; i < 16; ++i) fr[i] = WFRAG((c) * 16 + i); } while (0)
#define RT_MMA(fr, c) do { _Pragma("unroll") for (int s = 0; s < 8; ++s) { \
                    const int st = (c) * 8 + s, j = st / 3, nt = st % 3; \
                    u32x4 ah, al; \
                    _Pragma("unroll") for (int e = 0; e < 4; ++e) { const unsigned hp = cvt_pk_bf16(xv[8 * j + 2 * e], xv[8 * j + 2 * e + 1]); ah[e] = hp; \
                        al[e] = cvt_pk_bf16(xv[8 * j + 2 * e] - bf_lo(hp), xv[8 * j + 2 * e + 1] - bf_hi(hp)); } \
                    const u32x4 bh = fr[2 * s], bl = fr[2 * s + 1]; \
                    acc[nt] = __builtin_amdgcn_mfma_f32_16x16x32_bf16(__builtin_bit_cast(bf16x8, ah), __builtin_bit_cast(bf16x8, bh), acc[nt], 0, 0, 0); \
                    acc[nt] = __builtin_amdgcn_mfma_f32_16x16x32_bf16(__builtin_bit_cast(bf16x8, ah), __builtin_bit_cast(bf16x8, bl), acc[nt], 0, 0, 0); \
                    acc[nt] = __builtin_amdgcn_mfma_f32_16x16x32_bf16(__builtin_bit_cast(bf16x8, al), __builtin_bit_cast(bf16x8, bh), acc[nt], 0, 0, 0); } } while (0)
            RT_LOAD(frA, 0); RT_LOAD(frB, 1);
            RT_MMA(frA, 0);
            RT_LOAD(frA, 2);
            RT_MMA(frB, 1);
            RT_MMA(frA, 2);
#undef RT_LOAD
#undef RT_MMA
#pragma unroll
            for (int nt = 0; nt < 3; ++nt)
#pragma unroll
                for (int e = 0; e < 4; ++e) part[(w * 16 + 4 * q + e) * 48 + 16 * nt + r] = acc[nt][e];
#undef WFRAG
            __syncthreads();
            for (int o = tid; o < 16 * 36; o += 512) {
                const int rr = o / 36, c = o % 36; float s = 0.f;
#pragma unroll
                for (int i = 0; i < 8; ++i) s += part[(i * 16 + rr) * 48 + c];
                lgt[o] = s + (c < 4 ? a.in[12][l * 4 + c] : a.in[14][l * 32 + c - 4]);
            }
            __syncthreads();
            if (tid < 16) {
                const LAS float* sl = lgt + tid * 36; const int tt = rb * 16 + tid;
                int grp = 0; float m = sl[0];
                for (int g = 1; g < 4; ++g) if (sl[g] > m) { m = sl[g]; grp = g; }
                float se = 0.f;
                for (int g = 0; g < 4; ++g) se += __builtin_amdgcn_exp2f((sl[g] - m) * 1.4426950408889634f);
                const float pg = 1.0f / se;
                const LAS float* lgp = sl + 4 + grp * 8;
                const f32x4 l0 = *(const LAS f32x4*)lgp, l1 = *(const LAS f32x4*)(lgp + 4);
                const float lv[8] = {l0[0], l0[1], l0[2], l0[3], l1[0], l1[1], l1[2], l1[3]};
                int i0 = 0; float v0 = lv[0];
#pragma unroll
                for (int jx = 1; jx < 8; ++jx) if (lv[jx] > v0) { v0 = lv[jx]; i0 = jx; }
                int i1 = -1; float v1 = 0.f;
#pragma unroll
                for (int jx = 0; jx < 8; ++jx) if (jx != i0 && (i1 < 0 || lv[jx] > v1)) { v1 = lv[jx]; i1 = jx; }
                const float e1 = __builtin_amdgcn_exp2f((v1 - v0) * 1.4426950408889634f);
                const float p0 = 1.0f / (1.0f + e1), p1 = e1 / (1.0f + e1);
                float* tokw = (float*)(ws + WS_TOKW);
                tokw[2 * tt] = pg * p0; tokw[2 * tt + 1] = pg * p1;
                const int ai = ((rb & 3) * 16 + tid) * 2;
                rexp[ai] = grp * 8 + i0; rexp[ai + 1] = grp * 8 + i1;
            }
            if ((rb & 3) == 3) {
                __syncthreads();
                int e = 0, rk = 0;
                if (tid < 128) { e = rexp[tid]; rk = __hip_atomic_fetch_add(&lcnt[e], 1, __ATOMIC_RELAXED, __HIP_MEMORY_SCOPE_WORKGROUP); }
                __syncthreads();
                if (tid < 32) { const int c = lcnt[tid]; int bs = 0; if (c > 0) bs = atomicAdd((int*)(ws + WS_CNT) + l * NEXP + tid, c); lbase[tid] = bs; lcnt[tid] = 0; }
                __syncthreads();
                if (tid < 128) { int* slot = (int*)(ws + WS_SLOT); slot[(size_t)e * ECAP + lbase[e] + rk] = 2 * ((rb & ~3) * 16 + (tid >> 1)) + (tid & 1); }
            }
        }
        __syncthreads();
    }
}

namespace pg8 {
constexpr int BM = 256, BK = 64, HALF = 128, HTB = HALF * BK * 2, STAGE_BYTES = 8 * HTB, NXCD = 8, WGM = 8;
__device__ __forceinline__ int lds_byte(int r, int c) { const int st = (r >> 4) * 2 + (c >> 5), rr = r & 15, cc = c & 31, ob = rr * 64 + cc * 2; return st * 1024 + (ob ^ (((ob >> 9) & 1) << 5)); }
__device__ __forceinline__ void stage_rc(int b, int& R, int& C) { const int st = b / 1024, sb = b % 1024, swz = sb ^ (((sb >> 9) & 1) << 5); R = (st >> 1) * 16 + swz / 64; C = (st & 1) * 32 + (swz % 64) / 2; }
__device__ __forceinline__ int perm32(int rho) { const int n = rho >> 4, i = rho & 15; return 8 * (i >> 2) + 4 * n + (i & 3); }
struct Unit { int pm, pn, e, rows, ui; };

struct DenseOrder {
    static constexpr bool GATHER = false;
    int nM, nN, nwg, G, c; const bf16_t* Bt; int K;
    __device__ __forceinline__ void init(int M, int N, int K_, const bf16_t* Bt_, int G_, int c_) { nM = M / BM; nN = N / BM; nwg = nM * nN; G = G_; c = c_; Bt = Bt_; K = K_; }
    __device__ __forceinline__ bool next(int i, Unit& u) const {
        const long L = (long)i * G + c; if (L >= nwg) return false;
        int wgid = (int)L; { const int q = nwg / NXCD, r = nwg % NXCD, xcd = wgid % NXCD, off = wgid / NXCD; wgid = (xcd < r ? xcd * (q + 1) : r * (q + 1) + (xcd - r) * q) + off; }
        const int nig = WGM * nN, gid = wgid / nig, fm = gid * WGM, gsz = (nM - fm) < WGM ? (nM - fm) : WGM;
        u.pm = fm + ((wgid % nig) % gsz); u.pn = (wgid % nig) / gsz; u.e = 0; u.rows = 256; u.ui = i; return true;
    }
    __device__ __forceinline__ const char* bptr(const Unit& u) const { return (const char*)Bt + (size_t)u.pn * 256 * K * 2; }
    __device__ __forceinline__ unsigned arow(const Unit& u, int r) const { return (unsigned)(u.pm * 256 + r); }
};

#define PG8_SA(b, h) (((b) * 2 + (h)) * HTB)
#define PG8_SB(b, h) ((4 + (b) * 2 + (h)) * HTB)
#define PG8_STAGE(bufoff, gbase, voff) do { _Pragma("unroll") for (int _i = 0; _i < 2; ++_i) \
        __builtin_amdgcn_global_load_lds((const unsigned*)((const char*)(gbase) + (voff)[_i]), (LAS unsigned*)(lds + (bufoff) + ldsw + _i * 8192), 16, 0, 0); } while (0)
#define PG8_LDA(dst, b, h) do { _Pragma("unroll") for (int m = 0; m < 4; ++m) _Pragma("unroll") for (int k = 0; k < 2; ++k) dst[m][k] = *(const LAS bf16x8*)(lds + PG8_SA(b, h) + aoff + m * 2048 + k * 1024); } while (0)
#define PG8_LDB(dst, b, h) do { _Pragma("unroll") for (int n = 0; n < 2; ++n) _Pragma("unroll") for (int k = 0; k < 2; ++k) dst[n][k] = *(const LAS bf16x8*)(lds + PG8_SB(b, h) + boff + n * 2048 + k * 1024); } while (0)
#define PG8_MMA(ai, bj, At, Bt) do { __builtin_amdgcn_s_setprio(1); _Pragma("unroll") for (int m = 0; m < 4; ++m) _Pragma("unroll") for (int n = 0; n < 2; ++n) _Pragma("unroll") for (int k = 0; k < 2; ++k) \
        acc[ai][bj][m][n] = __builtin_amdgcn_mfma_f32_16x16x32_bf16(Bt[n][k], At[m][k], acc[ai][bj][m][n], 0, 0, 0); __builtin_amdgcn_s_setprio(0); } while (0)
#define PG8_WAIT_V(n) asm volatile("s_waitcnt vmcnt(" #n ")" ::: "memory")
#define PG8_WAIT_L(n) asm volatile("s_waitcnt lgkmcnt(" #n ")" ::: "memory")
#define PG8_BAR __builtin_amdgcn_s_barrier()
#define PG8_SCHED __builtin_amdgcn_sched_barrier(0)

#define PG8_STAGE_A(bufoff, h, nextu, kofs) do { \
        if constexpr (Sched::GATHER) { const char* _g = Ab + (kofs); unsigned _x[2]; \
            _x[0] = (nextu) ? ((h) ? no1[0] : no0[0]) : ((h) ? ao1[0] : ao0[0]); _x[1] = (nextu) ? ((h) ? no1[1] : no0[1]) : ((h) ? ao1[1] : ao0[1]); PG8_STAGE(bufoff, _g, _x); } \
        else { const char* _g = ((nextu) ? nA : cA) + (size_t)(h) * hstep + (kofs); PG8_STAGE(bufoff, _g, voffA); } } while (0)
template <class Epi, class Sched>
__device__ __forceinline__ void gemm_phase(LAS unsigned char* lds, const bf16_t* A, const int K, const Sched& S, const Epi& E, const int wv) {
    int tid = mk_tid(wv); asm volatile("" : "+v"(tid));
    const int wid = __builtin_amdgcn_readfirstlane(tid >> 6), lane = tid & 63, wr = wid >> 2, wc = wid & 3, fr = lane & 15, fq = lane >> 4;
    const int nt = K / BK;
    unsigned voffA[2], voffB[2];
#pragma unroll
    for (int i = 0; i < 2; ++i) { int R, C; stage_rc(tid * 16 + i * 8192, R, C); const int Rb = Epi::PERM ? ((R & ~31) + perm32(R & 31)) : R;
        voffA[i] = (unsigned)(R * K + C) * 2u; voffB[i] = (unsigned)(Rb * K + C) * 2u; }
    const size_t kstep = (size_t)(BK * 2);
    const size_t hstep = (size_t)HALF * K * 2;
    const size_t tstep = 2 * hstep;
    const unsigned ldsw = (unsigned)wid * 1024u;
    const int aoff = lds_byte(wr * 64 + fr, fq * 8), boff = lds_byte(wc * 32 + fr, fq * 8);
    Unit cur, nxt; int ui = 0;
    if (!S.next(0, cur)) return;
    f32x4 acc[2][2][4][2];
#pragma unroll
    for (int a_ = 0; a_ < 2; ++a_)
#pragma unroll
        for (int b_ = 0; b_ < 2; ++b_)
#pragma unroll
            for (int m = 0; m < 4; ++m)
#pragma unroll
                for (int n = 0; n < 2; ++n) acc[a_][b_][m][n] = (f32x4){0.f, 0.f, 0.f, 0.f};
    bf16x8 At[4][2], B0[2][2], B1[2][2];
    unsigned ao0[2] = {0u, 0u}, ao1[2] = {0u, 0u}, no0[2] = {0u, 0u}, no1[2] = {0u, 0u};
    const char* Ab = (const char*)A;
    const char* cA = Ab; const char* nA = Ab;
    if constexpr (Sched::GATHER) {
#pragma unroll
        for (int i = 0; i < 2; ++i) { int R, C; stage_rc(tid * 16 + i * 8192, R, C);
            ao0[i] = (S.arow(cur, R) * (unsigned)K + (unsigned)C) * 2u; ao1[i] = (S.arow(cur, HALF + R) * (unsigned)K + (unsigned)C) * 2u; }
    } else cA = Ab + (size_t)cur.pm * tstep;
    const char* cB = S.bptr(cur);
    PG8_STAGE(PG8_SB(0, 0), cB, voffB); PG8_STAGE_A(PG8_SA(0, 0), 0, false, 0); PG8_STAGE(PG8_SB(0, 1), cB + hstep, voffB); PG8_STAGE_A(PG8_SA(0, 1), 1, false, 0);
    if (wr == 1) PG8_BAR;
    PG8_WAIT_V(4); PG8_BAR;
    PG8_STAGE(PG8_SB(1, 0), cB + kstep, voffB); PG8_STAGE_A(PG8_SA(1, 0), 0, false, kstep); PG8_STAGE(PG8_SB(1, 1), cB + hstep + kstep, voffB);
    PG8_WAIT_V(6); PG8_BAR;
    for (;;) {
        const bool has_next = S.next(ui + 1, nxt);
        const char* nB = has_next ? S.bptr(nxt) : cB;
        if constexpr (Sched::GATHER) {
            if (has_next) {
#pragma unroll
                for (int i = 0; i < 2; ++i) { int R, C; stage_rc(tid * 16 + i * 8192, R, C);
                    no0[i] = (S.arow(nxt, R) * (unsigned)K + (unsigned)C) * 2u; no1[i] = (S.arow(nxt, HALF + R) * (unsigned)K + (unsigned)C) * 2u; }
            } else {
#pragma unroll
                for (int i = 0; i < 2; ++i) { no0[i] = ao0[i]; no1[i] = ao1[i]; }
            }
            asm volatile("s_waitcnt lgkmcnt(0)" ::: "memory");
            asm volatile("" : "+v"(no0[0]), "+v"(no0[1]), "+v"(no1[0]), "+v"(no1[1]));
        } else nA = has_next ? Ab + (size_t)nxt.pm * tstep : cA;
        for (int t = 0; t < nt; t += 2) {
            const bool last = (t == nt - 2);
            const size_t k1 = (size_t)(t + 1) * kstep;
            const size_t k2 = last ? 0 : (size_t)(t + 2) * kstep, k3 = k2 + kstep;
            const char* b2 = last ? nB : cB + (size_t)(t + 2) * kstep; const char* b3 = b2 + kstep;
            PG8_LDB(B0, 0, 0); PG8_SCHED; PG8_LDA(At, 0, 0); PG8_STAGE_A(PG8_SA(1, 1), 1, false, k1);
            PG8_WAIT_L(8); PG8_BAR; PG8_WAIT_L(0); PG8_MMA(0, 0, At, B0); PG8_BAR; PG8_SCHED;
            PG8_LDB(B1, 0, 1); PG8_STAGE(PG8_SB(0, 0), b2, voffB);
            PG8_BAR; PG8_WAIT_L(0); PG8_MMA(0, 1, At, B1); PG8_BAR;
            PG8_LDA(At, 0, 1); PG8_STAGE_A(PG8_SA(0, 0), 0, last, k2);
            PG8_BAR; PG8_WAIT_L(0); PG8_MMA(1, 0, At, B0); PG8_BAR; PG8_SCHED;
            PG8_STAGE(PG8_SB(0, 1), b2 + hstep, voffB);
            PG8_WAIT_V(6); PG8_BAR; PG8_MMA(1, 1, At, B1); PG8_BAR;
            PG8_LDB(B0, 1, 0); PG8_SCHED; PG8_LDA(At, 1, 0); PG8_STAGE_A(PG8_SA(0, 1), 1, last, k2);
            PG8_WAIT_L(8); PG8_BAR; PG8_WAIT_L(0); PG8_MMA(0, 0, At, B0); PG8_BAR; PG8_SCHED;
            PG8_LDB(B1, 1, 1); PG8_STAGE(PG8_SB(1, 0), b3, voffB);
            PG8_BAR; PG8_WAIT_L(0); PG8_MMA(0, 1, At, B1); PG8_BAR;
            PG8_LDA(At, 1, 1); PG8_STAGE_A(PG8_SA(1, 0), 0, last, k3);
            PG8_BAR; PG8_WAIT_L(0); PG8_MMA(1, 0, At, B0); PG8_BAR; PG8_SCHED;
            PG8_STAGE(PG8_SB(1, 1), b3 + hstep, voffB);
            PG8_WAIT_V(6); PG8_BAR; PG8_MMA(1, 1, At, B1); PG8_BAR;
        }
        E(acc, cur, wr, wc, fr, fq);
        if (!has_next) break;
#pragma unroll
        for (int a_ = 0; a_ < 2; ++a_)
#pragma unroll
            for (int b_ = 0; b_ < 2; ++b_)
#pragma unroll
                for (int m = 0; m < 4; ++m)
#pragma unroll
                    for (int n = 0; n < 2; ++n) acc[a_][b_][m][n] = (f32x4){0.f, 0.f, 0.f, 0.f};
        cur = nxt; cB = nB; cA = nA; ++ui;
#pragma unroll
        for (int i = 0; i < 2; ++i) { ao0[i] = no0[i]; ao1[i] = no1[i]; }
    }
    PG8_WAIT_V(0);
    if (wr == 0) PG8_BAR;
    PG8_BAR;
}

struct EpiInProj {
    static constexpr bool PERM = true;
    unsigned char* ws; float* kmean; const float* rope; const float* bcum;
    __device__ __forceinline__ void operator()(const f32x4 (&acc)[2][2][4][2], const Unit& u, int wr, int wc, int fr, int fq) const {
        const int row0 = u.pm * BM + wr * 64 + fr;
        const int lc = wc * 32 + 8 * fq;
        if (u.pn < 8) {
            const bool isq = u.pn < 4;
            bf16_t* dst = (bf16_t*)(ws + (isq ? WS_Q : WS_K));
            const int cb = (u.pn & 3) * 256;
            const float scale = isq ? QSCALE : 1.0f;
            float ks[2][8];
#pragma unroll
            for (int bj = 0; bj < 2; ++bj)
#pragma unroll
                for (int i = 0; i < 8; ++i) ks[bj][i] = 0.f;
            f32x4 rc[2][4];
#define ROPE_LOAD(buf, g) do { const int _pos = (row0 + ((g) >> 2) * HALF + ((g) & 3) * 16) & (SEQ - 1); const float* _rp = rope + _pos * 32 + 8 * (fq & 1); \
                rc[buf][0] = *(const f32x4*)_rp; rc[buf][1] = *(const f32x4*)(_rp + 4); rc[buf][2] = *(const f32x4*)(_rp + 16); rc[buf][3] = *(const f32x4*)(_rp + 20); } while (0)
            if (wc == 0) ROPE_LOAD(0, 0);
#pragma unroll
            for (int g = 0; g < 8; ++g) {
                const int ai = g >> 2, m = g & 3;
                const int r = row0 + ai * HALF + m * 16;
                if (wc == 0 && g + 1 < 8) ROPE_LOAD((g + 1) & 1, g + 1);
#pragma unroll
                for (int bj = 0; bj < 2; ++bj) {
                    float v[8] = {acc[ai][bj][m][0][0], acc[ai][bj][m][0][1], acc[ai][bj][m][0][2], acc[ai][bj][m][0][3],
                                  acc[ai][bj][m][1][0], acc[ai][bj][m][1][1], acc[ai][bj][m][1][2], acc[ai][bj][m][1][3]};
                    if (wc == 0) {
                        const f32x4 c0 = rc[g & 1][0], c1 = rc[g & 1][1], s0 = rc[g & 1][2], s1 = rc[g & 1][3];
                        const float cs[8] = {c0[0], c0[1], c0[2], c0[3], c1[0], c1[1], c1[2], c1[3]}, sn[8] = {s0[0], s0[1], s0[2], s0[3], s1[0], s1[1], s1[2], s1[3]};
#pragma unroll
                        for (int i = 0; i < 8; ++i) {
                            const float pv = __shfl_xor(v[i], 32);
                            v[i] = (fq < 2) ? (v[i] * cs[i] - pv * sn[i]) : (v[i] * cs[i] + pv * sn[i]);
                        }
                    }
                    if (!isq) {
#pragma unroll
                        for (int i = 0; i < 8; ++i) ks[bj][i] += v[i];
                    }
                    u32x4 o; o[0] = cvt_pk_bf16(v[0] * scale, v[1] * scale); o[1] = cvt_pk_bf16(v[2] * scale, v[3] * scale);
                    o[2] = cvt_pk_bf16(v[4] * scale, v[5] * scale); o[3] = cvt_pk_bf16(v[6] * scale, v[7] * scale);
                    __builtin_nontemporal_store(o, (u32x4*)(dst + ((size_t)((r >> 11) * 8 + (u.pn & 3) * 2 + bj) * SEQ + (r & (SEQ - 1))) * 128 + lc));
                }
            }
#undef ROPE_LOAD
            if (!isq) {
                const int b = u.pm >> 3, blk = u.pm & 7;
#pragma unroll
                for (int bj = 0; bj < 2; ++bj) {
                    const int h = (u.pn & 3) * 2 + bj;
#pragma unroll
                    for (int i = 0; i < 8; ++i) {
                        float s = ks[bj][i];
                        s += __shfl_xor(s, 1); s += __shfl_xor(s, 2); s += __shfl_xor(s, 4); s += __shfl_xor(s, 8);
                        if (fr == 0) atomicAdd(kmean + (((size_t)b * 8 + h) * 8 + blk) * 128 + lc + i, s * (1.0f / 256.0f));
                    }
                }
            }
        } else if (u.pn < 12) {
            bf16_t* dst = (bf16_t*)(ws + WS_VT);
#pragma unroll
            for (int ai = 0; ai < 2; ++ai)
#pragma unroll
                for (int m = 0; m < 4; ++m) {
                    const int r = row0 + ai * HALF + m * 16;
#pragma unroll
                    for (int bj = 0; bj < 2; ++bj) {
                        const f32x4 v0 = acc[ai][bj][m][0], v1 = acc[ai][bj][m][1];
                        u32x4 o; o[0] = cvt_pk_bf16(v0[0], v0[1]); o[1] = cvt_pk_bf16(v0[2], v0[3]); o[2] = cvt_pk_bf16(v1[0], v1[1]); o[3] = cvt_pk_bf16(v1[2], v1[3]);
                        __builtin_nontemporal_store(o, (u32x4*)(dst + ((size_t)((r >> 11) * 8 + (u.pn - 8) * 2 + bj) * SEQ + (r & (SEQ - 1))) * 128 + lc));
                    }
                }
        } else if (u.pn < 16) {
            const bool isq = u.pn < 14;
            const int cb = (u.pn - (isq ? 12 : 14)) * 256;
            bf16_t* d0 = (bf16_t*)(ws + (isq ? WS_QG : WS_KG));
            f32x4 bc[2][2];
#define BC_LOAD(buf, g) do { const int _r = row0 + ((g) >> 3) * HALF + (((g) >> 1) & 3) * 16, _col = cb + ((g) & 1) * HALF + lc; \
                bc[buf][0] = *(const f32x4*)(bcum + (size_t)_r * 512 + _col); bc[buf][1] = *(const f32x4*)(bcum + (size_t)_r * 512 + _col + 4); } while (0)
            BC_LOAD(0, 0);
#pragma unroll
            for (int g = 0; g < 16; ++g) {
                const int ai = g >> 3, m = (g >> 1) & 3, bj = g & 1;
                const int r = row0 + ai * HALF + m * 16;
                if (g + 1 < 16) BC_LOAD((g + 1) & 1, g + 1);
                {
                    {
                        const int col = cb + bj * HALF + lc;
                        const size_t hoff = ((size_t)((r >> 11) * 4 + (col >> 7)) * SEQ + (r & (SEQ - 1))) * 128 + (col & 127);
                        const f32x4 b0 = bc[g & 1][0], b1 = bc[g & 1][1];
                        const f32x4 v0 = acc[ai][bj][m][0], v1 = acc[ai][bj][m][1];
                        const float L2E = 1.4426950408889634f;
                        if (isq) {
                            const float s = 0.08838834764831845f;
                            u32x4 o; o[0] = cvt_pk_bf16(v0[0] * s * __builtin_amdgcn_exp2f(b0[0] * L2E), v0[1] * s * __builtin_amdgcn_exp2f(b0[1] * L2E));
                            o[1] = cvt_pk_bf16(v0[2] * s * __builtin_amdgcn_exp2f(b0[2] * L2E), v0[3] * s * __builtin_amdgcn_exp2f(b0[3] * L2E));
                            o[2] = cvt_pk_bf16(v1[0] * s * __builtin_amdgcn_exp2f(b1[0] * L2E), v1[1] * s * __builtin_amdgcn_exp2f(b1[1] * L2E));
                            o[3] = cvt_pk_bf16(v1[2] * s * __builtin_amdgcn_exp2f(b1[2] * L2E), v1[3] * s * __builtin_amdgcn_exp2f(b1[3] * L2E));
                            __builtin_nontemporal_store(o, (u32x4*)(d0 + hoff));
                        } else {
                            u32x4 o;
                            o[0] = cvt_pk_bf16(v0[0] * __builtin_amdgcn_exp2f(-b0[0] * L2E), v0[1] * __builtin_amdgcn_exp2f(-b0[1] * L2E));
                            o[1] = cvt_pk_bf16(v0[2] * __builtin_amdgcn_exp2f(-b0[2] * L2E), v0[3] * __builtin_amdgcn_exp2f(-b0[3] * L2E));
                            o[2] = cvt_pk_bf16(v1[0] * __builtin_amdgcn_exp2f(-b1[0] * L2E), v1[1] * __builtin_amdgcn_exp2f(-b1[1] * L2E));
                            o[3] = cvt_pk_bf16(v1[2] * __builtin_amdgcn_exp2f(-b1[2] * L2E), v1[3] * __builtin_amdgcn_exp2f(-b1[3] * L2E));
                            __builtin_nontemporal_store(o, (u32x4*)(d0 + hoff));
                        }
                    }
                }
            }
#undef BC_LOAD
        } else {
            const bool isog = u.pn >= 20;
            size_t woff; int cb;
            if (u.pn < 20) { woff = WS_VG; cb = (u.pn - 16) * 256; }
            else { woff = WS_OG; cb = (u.pn - 20) * 256; }
            bf16_t* dst = (bf16_t*)(ws + woff);
#pragma unroll
            for (int ai = 0; ai < 2; ++ai)
#pragma unroll
                for (int m = 0; m < 4; ++m) {
                    const int r = row0 + ai * HALF + m * 16;
#pragma unroll
                    for (int bj = 0; bj < 2; ++bj) {
                        f32x4 v0 = acc[ai][bj][m][0], v1 = acc[ai][bj][m][1];
                        if (isog) {
#pragma unroll
                            for (int i = 0; i < 4; ++i) { v0[i] = silu_fast(v0[i]); v1[i] = silu_fast(v1[i]); }
                        }
                        u32x4 o; o[0] = cvt_pk_bf16(v0[0], v0[1]); o[1] = cvt_pk_bf16(v0[2], v0[3]); o[2] = cvt_pk_bf16(v1[0], v1[1]); o[3] = cvt_pk_bf16(v1[2], v1[3]);
                        __builtin_nontemporal_store(o, (u32x4*)(dst + ((size_t)((r >> 11) * 4 + (cb >> 8)) * SEQ + (r & (SEQ - 1))) * 256 + bj * HALF + lc));
                    }
                }
        }
    }
};
struct EpiResGate {
    static constexpr bool PERM = false;
    const float* res; float* out; const float* gate;
    __device__ __forceinline__ void operator()(const f32x4 (&acc)[2][2][4][2], const Unit& u, int wr, int wc, int fr, int fq) const {
        const int row0 = u.pm * BM + wr * 64 + fr, col0 = u.pn * BM + wc * 32 + 4 * fq;
        const int b = u.pm >> 3;
        f32x4 gv[2][2];
#pragma unroll
        for (int bj = 0; bj < 2; ++bj)
#pragma unroll
            for (int n = 0; n < 2; ++n) gv[bj][n] = *(const f32x4*)(gate + (size_t)b * (6 * DM) + col0 + bj * HALF + n * 16);
#pragma unroll
        for (int ai = 0; ai < 2; ++ai) {
            f32x4 rv[4][2][2];
#pragma unroll
            for (int m = 0; m < 4; ++m) { const size_t off = (size_t)(row0 + ai * HALF + m * 16) * DM + col0;
#pragma unroll
                for (int bj = 0; bj < 2; ++bj)
#pragma unroll
                    for (int n = 0; n < 2; ++n) rv[m][bj][n] = *(const f32x4*)(res + off + bj * HALF + n * 16); }
#pragma unroll
            for (int m = 0; m < 4; ++m) { const size_t off = (size_t)(row0 + ai * HALF + m * 16) * DM + col0;
#pragma unroll
                for (int bj = 0; bj < 2; ++bj)
#pragma unroll
                    for (int n = 0; n < 2; ++n) *(f32x4*)(out + off + bj * HALF + n * 16) = rv[m][bj][n] + gv[bj][n] * acc[ai][bj][m][n]; }
            asm volatile("" ::: "memory");
        }
    }
};
struct MoeOrder {
    static constexpr bool GATHER = true;
    const int* slot; const bf16_t* Bt; int K, G, c, a_shift; const LAS int* tb;
    LAS int* rowtab;
    __device__ __forceinline__ bool next(int i, Unit& u) const {
        const int L = i * G + c, total = tb[32] * 8; if (L >= total || i >= 8) return false;
        const int mt = L >> 3; int e = 0;
        for (int j = 1; j < 32; ++j) e = (tb[j] <= mt) ? j : e;
        e = __builtin_amdgcn_readfirstlane(e);
        u.e = e; u.pm = mt - tb[e]; u.pn = L & 7; u.ui = i;
        const int rem = tb[33 + e] - u.pm * 256; u.rows = rem < 256 ? rem : 256; return true;
    }
    __device__ __forceinline__ const char* bptr(const Unit& u) const { return (const char*)Bt + ((size_t)u.e * 2048 + (size_t)u.pn * 256) * K * 2; }
    __device__ __forceinline__ unsigned arow(const Unit& u, int r) const { return (unsigned)(rowtab[u.ui * 256 + r] >> a_shift); }
    __device__ __forceinline__ void fill_rows(const int tid) const {
        Unit u;
        for (int i = 0; i < 8 && next(i, u); ++i)
            if (tid < 256) rowtab[i * 256 + tid] = slot[(size_t)u.e * ECAP + u.pm * 256 + (tid < u.rows ? tid : 0)];
        __syncthreads();
    }
};
__device__ __forceinline__ void moe_tiles(const int* cnt, LAS int* tb, const int wv) {
    if (mk_tid(wv) == 0) { int acc = 0; for (int e = 0; e < 32; ++e) { const int c = cnt[e]; tb[e] = acc; tb[33 + e] = c; acc += (c + 255) >> 8; } tb[32] = acc; }
    __syncthreads();
}
struct EpiMoe1 {
    static constexpr bool PERM = true;
    const LAS int* rowtab; bf16_t* act;
    __device__ __forceinline__ void operator()(const f32x4 (&acc)[2][2][4][2], const Unit& u, int wr, int wc, int fr, int fq) const {
        const int lc = u.pn * 128 + wc * 32 + 8 * fq;
#pragma unroll
        for (int ai = 0; ai < 2; ++ai)
#pragma unroll
            for (int m = 0; m < 4; ++m) {
                const int r = ai * HALF + wr * 64 + m * 16 + fr;
                if (r < u.rows) {
                    const int asg = rowtab[u.ui * 256 + r];
                    float o[8];
#pragma unroll
                    for (int n = 0; n < 2; ++n)
#pragma unroll
                        for (int j = 0; j < 4; ++j) { const float g = acc[ai][0][m][n][j], up = acc[ai][1][m][n][j]; o[4 * n + j] = silu_fast(g) * up; }
                    u32x4 w; w[0] = cvt_pk_bf16(o[0], o[1]); w[1] = cvt_pk_bf16(o[2], o[3]); w[2] = cvt_pk_bf16(o[4], o[5]); w[3] = cvt_pk_bf16(o[6], o[7]);
                    *(u32x4*)(act + (size_t)asg * DEXP + lc) = w;
                }
            }
    }
};
struct EpiMoe2 {
    static constexpr bool PERM = true;
    const LAS int* rowtab; bf16_t* yb;
    __device__ __forceinline__ void operator()(const f32x4 (&acc)[2][2][4][2], const Unit& u, int wr, int wc, int fr, int fq) const {
        const int lc = u.pn * 256 + wc * 32 + 8 * fq;
#pragma unroll
        for (int ai = 0; ai < 2; ++ai)
#pragma unroll
            for (int m = 0; m < 4; ++m) {
                const int r = ai * HALF + wr * 64 + m * 16 + fr;
                if (r < u.rows) {
                    const int asg = rowtab[u.ui * 256 + r];
#pragma unroll
                    for (int bj = 0; bj < 2; ++bj) {
                        const f32x4 v0 = acc[ai][bj][m][0], v1 = acc[ai][bj][m][1];
                        u32x4 w; w[0] = cvt_pk_bf16(v0[0], v0[1]); w[1] = cvt_pk_bf16(v0[2], v0[3]); w[2] = cvt_pk_bf16(v1[0], v1[1]); w[3] = cvt_pk_bf16(v1[2], v1[3]);
                        *(u32x4*)(yb + (size_t)asg * DM + lc + bj * HALF) = w;
                    }
                }
            }
    }
};
}

namespace attn {
typedef float f32x16 __attribute__((ext_vector_type(16)));
typedef short s16x4 __attribute__((ext_vector_type(4)));
constexpr int KSTR = 272, VSTR = 320, KT_BYTES = 64 * KSTR, VT_BYTES = 64 * VSTR;
constexpr int L_KM = 0, L_K = 4096, L_V = L_K + 2 * KT_BYTES, L_END = L_V + 2 * VT_BYTES;

__device__ __forceinline__ float bf2f(short s) { return __uint_as_float(((unsigned)(unsigned short)s) << 16); }

__device__ __forceinline__ void attn_unit(LAS unsigned char* lds, const bf16_t* Q, const bf16_t* K, const bf16_t* Vt, const float* kmean, bf16_t* mix,
                                          const int b, const int h, const int blk, const int wv) {
    int tid = mk_tid(wv); asm volatile("" : "+v"(tid));
    const int w = __builtin_amdgcn_readfirstlane(tid >> 6), lane = tid & 63, j = lane & 31, hh = lane >> 5;
    LAS float* km = (LAS float*)(lds + L_KM);
    __syncthreads();
    {
        const float* kp = kmean + ((size_t)(b * 8 + h) * 8) * 128;
        km[2 * tid] = kp[2 * tid]; km[2 * tid + 1] = kp[2 * tid + 1];
    }
    const size_t qrow = (size_t)b * SEQ + blk * 256 + 32 * w + j;
    const size_t hbase = (size_t)(b * 8 + h) * SEQ;
    bf16x8 qf[8];
#pragma unroll
    for (int ks = 0; ks < 8; ++ks) qf[ks] = *(const bf16x8*)(Q + (hbase + blk * 256 + 32 * w + j) * 128 + 16 * ks + 8 * hh);
    const int ntile = 4 + 4 * blk;
    u32x4 krA[2], vrA[2], krB[2], vrB[2];
#define ATT_KEY0(ti) (((ti) < 4) ? (blk * 256 + 64 * (ti)) : ((((ti) - 4) >> 2) * 256 + 64 * (((ti) - 4) & 3)))
#define ATT_LOAD(kr, vr, ti) do { const int _k0 = ATT_KEY0(ti); _Pragma("unroll") for (int _i = 0; _i < 2; ++_i) { const int _c = tid + 512 * _i; \
        kr[_i] = *(const u32x4*)(K + (hbase + _k0) * 128 + (size_t)_c * 8); \
        vr[_i] = *(const u32x4*)(Vt + (hbase + _k0) * 128 + (size_t)_c * 8); } } while (0)
#define ATT_STORE(kr, vr, buf) do { _Pragma("unroll") for (int _i = 0; _i < 2; ++_i) { const int _c = tid + 512 * _i; \
        *(LAS u32x4*)(lds + L_K + (buf) * KT_BYTES + (_c >> 4) * KSTR + (_c & 15) * 16) = kr[_i]; \
        *(LAS u32x4*)(lds + L_V + (buf) * VT_BYTES + (_c >> 4) * VSTR + (_c & 15) * 16) = vr[_i]; } } while (0)
    ATT_LOAD(krA, vrA, 0);
    __syncthreads();
    unsigned sel = 0u;
    {
        float g[7];
#pragma unroll
        for (int n = 0; n < 7; ++n) {
            float p = 0.f;
            if (n < blk) {
#pragma unroll
                for (int ks = 0; ks < 8; ++ks) {
                    const f32x4 k0 = *(const LAS f32x4*)&km[n * 128 + 16 * ks + 8 * hh], k1 = *(const LAS f32x4*)&km[n * 128 + 16 * ks + 8 * hh + 4];
                    p += bf2f(qf[ks][0]) * k0[0] + bf2f(qf[ks][1]) * k0[1] + bf2f(qf[ks][2]) * k0[2] + bf2f(qf[ks][3]) * k0[3]
                       + bf2f(qf[ks][4]) * k1[0] + bf2f(qf[ks][5]) * k1[1] + bf2f(qf[ks][6]) * k1[2] + bf2f(qf[ks][7]) * k1[3];
                }
            }
            g[n] = p + __shfl_xor(p, 32);
        }
#pragma unroll
        for (int n = 0; n < 7; ++n) {
            int rank = 0;
#pragma unroll
            for (int m2 = 0; m2 < 7; ++m2) if (m2 != n && m2 < blk) rank += (g[m2] > g[n] || (g[m2] == g[n] && m2 < n)) ? 1 : 0;
            if (n < blk && rank < 3) sel |= 1u << n;
        }
    }
    ATT_STORE(krA, vrA, 0);
    if (ntile > 1) ATT_LOAD(krA, vrA, 1);
    __syncthreads();
    f32x16 o[4];
#pragma unroll
    for (int d = 0; d < 4; ++d)
#pragma unroll
        for (int r = 0; r < 16; ++r) o[d][r] = 0.f;
    float mrun = -1e30f, lsum = 0.f;
#define ATT_TILE(TI, KX, VX, KY, VY) do { const int ti = (TI); \
        const int buf = ti & 1; \
        if (ti + 2 < ntile) ATT_LOAD(KY, VY, ti + 2); \
        bool active, diag = false, lsel = true; \
        if (ti < 4) { active = (ti <= (w >> 1)); diag = (ti == (w >> 1)); } \
        else { lsel = ((sel >> ((ti - 4) >> 2)) & 1u) != 0u; active = __builtin_amdgcn_ballot_w64(lsel) != 0ull; } \
        if (active) { \
            f32x16 s0, s1; \
_Pragma("unroll") \
            for (int r = 0; r < 16; ++r) { s0[r] = 0.f; s1[r] = 0.f; } \
            const LAS unsigned char* kb = lds + L_K + buf * KT_BYTES + j * KSTR + hh * 16; \
_Pragma("unroll") \
            for (int ks = 0; ks < 8; ++ks) { \
                const bf16x8 a0 = *(const LAS bf16x8*)(kb + ks * 32), a1 = *(const LAS bf16x8*)(kb + 32 * KSTR + ks * 32); \
                s0 = __builtin_amdgcn_mfma_f32_32x32x16_bf16(a0, qf[ks], s0, 0, 0, 0); \
                s1 = __builtin_amdgcn_mfma_f32_32x32x16_bf16(a1, qf[ks], s1, 0, 0, 0); \
            } \
            const LAS unsigned char* vb = lds + L_V + buf * VT_BYTES + (((lane & 15) >> 2) + 4 * hh) * VSTR + (16 * ((lane >> 4) & 1) + 4 * (lane & 3)) * 2; \
_Pragma("unroll") \
            for (int u = 0; u < 2; ++u) { \
                f32x16& sx = u ? s1 : s0; \
                if (diag) { \
                    const int ql = 32 * w + j - 64 * ti - 32 * u; \
_Pragma("unroll") \
                    for (int r = 0; r < 16; ++r) { const int kr_ = (r & 3) + 8 * (r >> 2) + 4 * hh; if (kr_ > ql) sx[r] = -INFINITY; } \
                } \
                if (!lsel) { \
_Pragma("unroll") \
                    for (int r = 0; r < 16; ++r) sx[r] = -INFINITY; \
                } \
                float mnew = mrun, alpha = 1.0f; \
                if (ti < 4) { \
                    float mx = sx[0]; \
_Pragma("unroll") \
                    for (int r = 1; r < 16; ++r) mx = fmaxf(mx, sx[r]); \
                    mx = fmaxf(mx, __shfl_xor(mx, 32)); \
                    mnew = fmaxf(mrun, mx); alpha = __builtin_amdgcn_exp2f(mrun - mnew); mrun = mnew; \
                } \
                float ps = 0.f; \
_Pragma("unroll") \
                for (int r = 0; r < 16; ++r) { sx[r] = __builtin_amdgcn_exp2f(sx[r] - mnew); ps += sx[r]; } \
                lsum = lsum * alpha + ps; \
                if (ti < 4 && __builtin_amdgcn_ballot_w64(alpha != 1.0f) != 0ull) { \
_Pragma("unroll") \
                    for (int d = 0; d < 4; ++d) \
_Pragma("unroll") \
                        for (int r = 0; r < 16; ++r) o[d][r] *= alpha; \
                } \
                bf16x8 pk[2]; \
_Pragma("unroll") \
                for (int s2 = 0; s2 < 2; ++s2) { \
                    u32x4 t0; \
_Pragma("unroll") \
                    for (int e = 0; e < 4; ++e) t0[e] = cvt_pk_bf16(sx[8 * s2 + 2 * e], sx[8 * s2 + 2 * e + 1]); \
                    pk[s2] = __builtin_bit_cast(bf16x8, t0); \
                } \
_Pragma("unroll") \
                for (int d = 0; d < 4; ++d) \
_Pragma("unroll") \
                    for (int s2 = 0; s2 < 2; ++s2) { \
                        const LAS unsigned char* vp = vb + (32 * u + 16 * s2) * VSTR + d * 64; \
                        const s16x4 x0 = __builtin_amdgcn_ds_read_tr16_b64_v4i16((LAS s16x4*)vp), x1 = __builtin_amdgcn_ds_read_tr16_b64_v4i16((LAS s16x4*)(vp + 8 * VSTR)); \
                        const bf16x8 av = (bf16x8){x0[0], x0[1], x0[2], x0[3], x1[0], x1[1], x1[2], x1[3]}; \
                        o[d] = __builtin_amdgcn_mfma_f32_32x32x16_bf16(av, pk[s2], o[d], 0, 0, 0); \
                    } \
            } \
        } \
        if (ti + 1 < ntile) ATT_STORE(KX, VX, buf ^ 1); \
        __syncthreads(); \
    } while (0)
    for (int t2 = 0; t2 < ntile; t2 += 2) {
        ATT_TILE(t2, krA, vrA, krB, vrB);
        if (t2 + 1 < ntile) ATT_TILE(t2 + 1, krB, vrB, krA, vrA);
    }
#undef ATT_TILE
#undef ATT_LOAD
#undef ATT_KEY0
#undef ATT_STORE
    lsum += __shfl_xor(lsum, 32);
    const float inv = 1.0f / lsum;
    bf16_t* op = mix + qrow * DM + h * 128 + 4 * hh;
#pragma unroll
    for (int d = 0; d < 4; ++d)
#pragma unroll
        for (int rg = 0; rg < 4; ++rg) {
            u32x2 wv; wv[0] = cvt_pk_bf16(o[d][4 * rg] * inv, o[d][4 * rg + 1] * inv); wv[1] = cvt_pk_bf16(o[d][4 * rg + 2] * inv, o[d][4 * rg + 3] * inv);
            *(u32x2*)(op + 32 * d + 8 * rg) = wv;
        }
}

__device__ __forceinline__ void attn_phase(LAS unsigned char* lds, const unsigned char* ws, unsigned* queue, const int l, const int wv) {
    const bf16_t* Q = (const bf16_t*)(ws + WS_Q); const bf16_t* K = (const bf16_t*)(ws + WS_K); const bf16_t* Vt = (const bf16_t*)(ws + WS_VT);
    const float* kmean = (const float*)(ws + WS_KMEAN) + (size_t)l * 8 * 8 * 8 * 128;
    bf16_t* mix = (bf16_t*)(ws + WS_MIX);
    LAS int* slot = (LAS int*)(lds + L_END);
    for (;;) {
        __syncthreads();
        if (mk_tid(wv) == 0) *slot = (int)atomicAdd(queue, 1u);
        __syncthreads();
        const int u = *slot;
        if (u >= 512) break;
        const int blk = 7 - (u >> 6), bh = u & 63;
        attn_unit(lds, Q, K, Vt, kmean, mix, bh >> 3, bh & 7, blk, wv);
    }
}
__device__ __forceinline__ void attn_cvt_phase(const MkArgs& a, LAS unsigned char* lds, unsigned* aqueue, unsigned* cqueue, const int l, const int clo, const int chi, const int cper, const int wv) {
    const unsigned char* ws = a.ws;
    const bf16_t* Q = (const bf16_t*)(ws + WS_Q); const bf16_t* K = (const bf16_t*)(ws + WS_K); const bf16_t* Vt = (const bf16_t*)(ws + WS_VT);
    const float* kmean = (const float*)(ws + WS_KMEAN) + (size_t)l * 8 * 8 * 8 * 128;
    bf16_t* mix = (bf16_t*)(ws + WS_MIX);
    LAS int* slot = (LAS int*)(lds + L_END);
    bool adone = false, cdone = (clo >= chi);
    int turn = (int)blockIdx.x & 1;
    while (!(adone && cdone)) {
        if (turn == 0) {
            if (!adone) {
                __syncthreads();
                if (mk_tid(wv) == 0) *slot = (int)atomicAdd(aqueue, 1u);
                __syncthreads();
                const int u = *slot;
                if (u >= 512) adone = true;
                else {
                    int blk, bh;
                    if (u < 320) { bh = u / 5; blk = 7 - (u - 5 * bh); } else { const int v = u - 320; blk = 2 - (v >> 6); bh = v & 63; }
                    attn_unit(lds, Q, K, Vt, kmean, mix, bh >> 3, bh & 7, blk, wv); }
            }
        } else if (!cdone) {
            __syncthreads();
            if (mk_tid(wv) == 0) *slot = clo + (int)atomicAdd(cqueue, (unsigned)cper);
            __syncthreads();
            const int base = *slot;
            if (base >= chi) cdone = true;
            else { int tid = mk_tid(wv); asm volatile("" : "+v"(tid)); cvt_range(a, lds, tid, base, 1, (base + cper < chi) ? base + cper : chi, true); }
        }
        turn ^= 1;
    }
}
}

namespace gla {
typedef float f32x16 __attribute__((ext_vector_type(16)));
typedef short s16x4 __attribute__((ext_vector_type(4)));
constexpr int QS = 272, ES = 320, VS = 576, OS = 260;
constexpr int L_Q = 0, L_K = L_Q + 64 * QS, L_OB = 0, L_KE = 64 * OS * 4, L_V = L_KE + 64 * ES, L_FR = L_V + 64 * VS, L_DEC = L_FR + 3 * 2 * 64 * 16, L_GON = L_DEC + 512, L_END = L_GON + 1024;
static_assert(L_K + 64 * QS <= L_KE, "obuf (f32 [64][OS]) covers q~ and k~, which are dead when it is written");
static_assert(L_END <= 160 * 1024 - 64, "LDS budget");

__device__ __forceinline__ bf16x8 ld2x64(const LAS unsigned char* p) {
    const u32x2 lo = *(const LAS u32x2*)p, hi = *(const LAS u32x2*)(p + 16);
    return __builtin_bit_cast(bf16x8, (u32x4){lo[0], lo[1], hi[0], hi[1]});
}
__device__ __forceinline__ bf16x8 tr8(const LAS unsigned char* p0, const LAS unsigned char* p1) {
    const s16x4 a = __builtin_amdgcn_ds_read_tr16_b64_v4i16((LAS s16x4*)p0), b = __builtin_amdgcn_ds_read_tr16_b64_v4i16((LAS s16x4*)p1);
    return (bf16x8){a[0], a[1], a[2], a[3], b[0], b[1], b[2], b[3]};
}
__device__ __forceinline__ bf16x8 pack8(const f32x16& x, const int s2) {
    u32x4 t;
#pragma unroll
    for (int e = 0; e < 4; ++e) t[e] = cvt_pk_bf16(x[8 * s2 + 2 * e], x[8 * s2 + 2 * e + 1]);
    return __builtin_bit_cast(bf16x8, t);
}

__device__ __forceinline__ void gla_unit(LAS unsigned char* lds, const unsigned char* ws, const float* g_onorm, const int b, const int h, const int wv) {
    int tid = mk_tid(wv); asm volatile("" : "+v"(tid));
    const int w = __builtin_amdgcn_readfirstlane(tid >> 6), lane = tid & 63, j = lane & 31, hh = lane >> 5;
    const bf16_t* QG = (const bf16_t*)(ws + WS_QG); const bf16_t* KG = (const bf16_t*)(ws + WS_KG);
    const bf16_t* VG = (const bf16_t*)(ws + WS_VG); const bf16_t* OG = (const bf16_t*)(ws + WS_OG);
    const float* BC = (const float*)(ws + WS_LA); bf16_t* mix = (bf16_t*)(ws + WS_MIX);
    LAS float* dec = (LAS float*)(lds + L_DEC); LAS float* gon = (LAS float*)(lds + L_GON); LAS float* obuf = (LAS float*)(lds + L_OB);
    f32x16 S[4];
#pragma unroll
    for (int et = 0; et < 4; ++et)
#pragma unroll
        for (int r = 0; r < 16; ++r) S[et][r] = 0.f;
    __syncthreads();
    if (tid < 256) gon[tid] = g_onorm[tid];
    u32x4 qr[2][2], kr[2][2], vr[2][4], ogr[4]; f32x4 dr = (f32x4){0.f, 0.f, 0.f, 0.f};
    const unsigned o16 = (unsigned)tid * 16u, oog = (unsigned)tid * 64u;
#define GLA_LOAD(ps, n) do { const size_t _t0 = ((size_t)(b * 4 + h) * SEQ + 64 * (n)); \
        const char* _qb = (const char*)(QG + _t0 * 128); const char* _kb = (const char*)(KG + _t0 * 128); \
        const char* _vb = (const char*)(VG + _t0 * 256); \
        _Pragma("unroll") for (int _i = 0; _i < 2; ++_i) { qr[ps][_i] = *(const u32x4*)(_qb + _i * 8192 + o16); kr[ps][_i] = *(const u32x4*)(_kb + _i * 8192 + o16); } \
        _Pragma("unroll") for (int _i = 0; _i < 4; ++_i) vr[ps][_i] = *(const u32x4*)(_vb + _i * 8192 + o16); \
        } while (0)
#define GLA_LOAD_DR(n) do { if (tid < 32) dr = *(const f32x4*)(BC + ((size_t)b * SEQ + 64 * (n) + 63) * 512 + h * 128 + tid * 4); } while (0)
    const LAS unsigned char* qb8 = lds + L_Q + j * QS + hh * 8;  const LAS unsigned char* qb16 = lds + L_Q + j * QS + hh * 16;
    const LAS unsigned char* kb16 = lds + L_K + j * QS + hh * 16;
    const int li = lane & 15, gq = li >> 2, gp = li & 3, gg = (lane >> 4) & 1;
    const LAS unsigned char* keN = lds + L_KE + (gq + 8 * hh) * ES + (16 * gg + 4 * gp) * 2;
    const LAS unsigned char* vN = lds + L_V + (gq + 8 * hh) * VS + (32 * w + 16 * gg + 4 * gp) * 2;
    const LAS unsigned char* vP = lds + L_V + (gq + 4 * hh) * VS + (32 * w + 16 * gg + 4 * gp) * 2;
    const LAS float* decb = dec + 4 * hh; LAS float* ob = obuf + 4 * hh * OS + 32 * w + j;
    LAS unsigned char* frb = lds + L_FR + lane * 16;
#define GLA_LOAD_OG(ps, n) do { const char* _ob = (const char*)(OG + ((size_t)(b * 4 + h) * SEQ + 64 * (n)) * 256); \
        _Pragma("unroll") for (int x = 0; x < 4; ++x) ogr[x] = *(const u32x4*)(_ob + oog + x * 16); } while (0)
    GLA_LOAD(0, 0); GLA_LOAD_DR(0); GLA_LOAD(1, 1);
    for (int n2 = 0; n2 < SEQ / 64; n2 += 2)
#pragma unroll
    for (int par = 0; par < 2; ++par) {
        const int n = n2 + par;
        const size_t t0 = (size_t)b * SEQ + 64 * n;
        __syncthreads();
#pragma unroll
        for (int i = 0; i < 2; ++i) { const int c = tid + 512 * i, row = c >> 4, cc = (c & 15) * 16;
            *(LAS u32x4*)(lds + L_Q + row * QS + cc) = qr[par][i]; *(LAS u32x4*)(lds + L_K + row * QS + cc) = kr[par][i]; }
#pragma unroll
        for (int i = 0; i < 4; ++i) { const int c = tid + 512 * i; *(LAS u32x4*)(lds + L_V + (c >> 5) * VS + (c & 31) * 16) = vr[par][i]; }
        if (tid < 32) {
            const float L2E_ = 1.4426950408889634f;
            *(LAS f32x4*)&dec[tid * 4] = (f32x4){__builtin_amdgcn_exp2f(dr[0] * L2E_), __builtin_amdgcn_exp2f(dr[1] * L2E_), __builtin_amdgcn_exp2f(dr[2] * L2E_), __builtin_amdgcn_exp2f(dr[3] * L2E_)};
        }
        __syncthreads();
        GLA_LOAD_OG(0, n);
#pragma unroll
        for (int i = 0; i < 2; ++i) {
            const int c = tid + 512 * i, row = c >> 4, kc = (c & 15) * 8;
            const f32x4 d0 = *(const LAS f32x4*)&dec[kc], d1 = *(const LAS f32x4*)&dec[kc + 4];
            const u32x4 kv = kr[par][i]; u32x4 ke;
            ke[0] = cvt_pk_bf16(bf_lo(kv[0]) * d0[0], bf_hi(kv[0]) * d0[1]); ke[1] = cvt_pk_bf16(bf_lo(kv[1]) * d0[2], bf_hi(kv[1]) * d0[3]);
            ke[2] = cvt_pk_bf16(bf_lo(kv[2]) * d1[0], bf_hi(kv[2]) * d1[1]); ke[3] = cvt_pk_bf16(bf_lo(kv[3]) * d1[2], bf_hi(kv[3]) * d1[3]);
            *(LAS u32x4*)(lds + L_KE + row * ES + (c & 15) * 16) = ke;
        }
        if (n + 1 < SEQ / 64) GLA_LOAD_DR(n + 1);
        if (n + 2 < SEQ / 64) GLA_LOAD(par, n + 2);
        if (w < 3) {
            const int st = (w == 2) ? 1 : 0, tt = (w == 0) ? 0 : 1;
            f32x16 X;
#pragma unroll
            for (int r = 0; r < 16; ++r) X[r] = 0.f;
#pragma unroll
            for (int ks = 0; ks < 8; ++ks) {
                const bf16x8 ak = *(const LAS bf16x8*)(kb16 + 32 * st * QS + ks * 32);
                const bf16x8 bq2 = *(const LAS bf16x8*)(qb16 + 32 * tt * QS + ks * 32);
                X = __builtin_amdgcn_mfma_f32_32x32x16_bf16(ak, bq2, X, 0, 0, 0);
            }
            if (st == tt) {
#pragma unroll
                for (int r = 0; r < 16; ++r) { const int sr = (r & 3) + 8 * (r >> 2) + 4 * hh; if (sr > j) X[r] = 0.f; }
            }
            *(LAS bf16x8*)(frb + (w * 2 + 0) * 1024) = pack8(X, 0); *(LAS bf16x8*)(frb + (w * 2 + 1) * 1024) = pack8(X, 1);
        }
        f32x16 O[2];
#pragma unroll
        for (int tt = 0; tt < 2; ++tt)
#pragma unroll
            for (int r = 0; r < 16; ++r) O[tt][r] = 0.f;
#pragma unroll
        for (int et = 0; et < 4; ++et)
#pragma unroll
            for (int s2 = 0; s2 < 2; ++s2) {
                const bf16x8 sb = pack8(S[et], s2);
#pragma unroll
                for (int tt = 0; tt < 2; ++tt) {
                    const bf16x8 aq = ld2x64(qb8 + 32 * tt * QS + (32 * et + 16 * s2) * 2);
                    O[tt] = __builtin_amdgcn_mfma_f32_32x32x16_bf16(aq, sb, O[tt], 0, 0, 0);
                }
            }
        __syncthreads();
#pragma unroll
        for (int pr = 0; pr < 3; ++pr) {
            const int st = (pr == 2) ? 1 : 0, tt = (pr == 0) ? 0 : 1;
#pragma unroll
            for (int s2 = 0; s2 < 2; ++s2) {
                const bf16x8 ax = *(const LAS bf16x8*)(frb + (pr * 2 + s2) * 1024);
                const LAS unsigned char* vp = vP + (32 * st + 16 * s2) * VS;
                const bf16x8 bv = tr8(vp, vp + 8 * VS);
                O[tt] = __builtin_amdgcn_mfma_f32_32x32x16_bf16(ax, bv, O[tt], 0, 0, 0);
            }
        }
        __builtin_amdgcn_sched_barrier(0);
#pragma unroll
        for (int tt = 0; tt < 2; ++tt)
#pragma unroll
            for (int r = 0; r < 16; ++r) ob[(32 * tt + (r & 3) + 8 * (r >> 2)) * OS] = O[tt][r];
        __builtin_amdgcn_sched_barrier(0);
#pragma unroll
        for (int et = 0; et < 4; ++et)
#pragma unroll
            for (int rg = 0; rg < 4; ++rg) { const f32x4 dl = *(const LAS f32x4*)&decb[32 * et + 8 * rg];
#pragma unroll
                for (int x = 0; x < 4; ++x) S[et][4 * rg + x] *= dl[x]; }
#pragma unroll
        for (int ks = 0; ks < 4; ++ks) {
            const LAS unsigned char* vp = vN + 16 * ks * VS;
            const bf16x8 bv = tr8(vp, vp + 4 * VS);
#pragma unroll
            for (int et = 0; et < 4; ++et) {
                const LAS unsigned char* kp = keN + 32 * et * 2 + 16 * ks * ES;
                const bf16x8 ak = tr8(kp, kp + 4 * ES);
                S[et] = __builtin_amdgcn_mfma_f32_32x32x16_bf16(ak, bv, S[et], 0, 0, 0);
            }
        }
        __syncthreads();
        {
            const int t = tid >> 3, g8 = tid & 7;
            float ov[32]; float ss = 0.f;
#pragma unroll
            for (int x = 0; x < 8; ++x) { const f32x4 v = *(const LAS f32x4*)&obuf[t * OS + 32 * g8 + 4 * x]; ov[4 * x] = v[0]; ov[4 * x + 1] = v[1]; ov[4 * x + 2] = v[2]; ov[4 * x + 3] = v[3];
                ss += v[0] * v[0] + v[1] * v[1] + v[2] * v[2] + v[3] * v[3]; }
            ss += __builtin_bit_cast(float, __builtin_amdgcn_ds_swizzle(__builtin_bit_cast(int, ss), (1 << 10) | 0x1F)); ss += __builtin_bit_cast(float, __builtin_amdgcn_ds_swizzle(__builtin_bit_cast(int, ss), (2 << 10) | 0x1F));
            ss += __builtin_bit_cast(float, __builtin_amdgcn_ds_swizzle(__builtin_bit_cast(int, ss), (4 << 10) | 0x1F));
            const float rstd = __builtin_amdgcn_rsqf(ss * (1.0f / 256.0f) + EPSV);
            bf16_t* mp = mix + (t0 + t) * DM + 1024 + h * 256 + 32 * g8;
#pragma unroll
            for (int x = 0; x < 4; ++x) {
                const u32x4 og = ogr[x];
                const f32x4 g0 = *(const LAS f32x4*)&gon[32 * g8 + 8 * x], g1 = *(const LAS f32x4*)&gon[32 * g8 + 8 * x + 4];
                const float gg2[8] = {g0[0], g0[1], g0[2], g0[3], g1[0], g1[1], g1[2], g1[3]};
                float res[8];
#pragma unroll
                for (int y = 0; y < 4; ++y) { const float a0 = bf_lo(og[y]), a1 = bf_hi(og[y]);
                    res[2 * y] = ov[8 * x + 2 * y] * rstd * gg2[2 * y] * a0;
                    res[2 * y + 1] = ov[8 * x + 2 * y + 1] * rstd * gg2[2 * y + 1] * a1; }
                u32x4 wv4; wv4[0] = cvt_pk_bf16(res[0], res[1]); wv4[1] = cvt_pk_bf16(res[2], res[3]); wv4[2] = cvt_pk_bf16(res[4], res[5]); wv4[3] = cvt_pk_bf16(res[6], res[7]);
                *(u32x4*)(mp + 8 * x) = wv4;
            }
        }
    }
#undef GLA_LOAD
#undef GLA_LOAD_OG
#undef GLA_LOAD_DR
}
}

__device__ __forceinline__ int moe_idle_wgs(const int* cnt0, const int G) {
    int tiles = 0;
    for (int e = 0; e < NEXP; ++e) tiles += (cnt0[e] + 255) >> 8;
    const int rem = (tiles * 8) % G;
    return rem ? G - rem : 0;
}
constexpr int DEF_RES13 = 2560;
constexpr int DEF_TPB6 = 0, DEF_TPB7 = 0;
__global__ void __launch_bounds__(512, 2) mk_fwd(MkArgs a) {
    extern __shared__ __attribute__((aligned(16))) unsigned char lds_raw[];
    LAS unsigned char* lds = (LAS unsigned char*)lds_raw;
    volatile LAS unsigned* misc = (volatile LAS unsigned*)(lds + LDS_MISC);
    const int wv = __builtin_amdgcn_readfirstlane((int)threadIdx.x >> 6);
    { const int t0_ = mk_tid(wv); if (t0_ < 4) misc[t0_] = 0u; }
    __syncthreads();
    const int lo = a.ph_lo, hi = a.ph_hi;
    unsigned char* ws = a.ws;
    XcdBarrier bar; bar.bar = (unsigned*)(ws + WS_CTL); bar.x = 0; bar.st = misc; bar.wv = wv;
    if (hi - lo > 1) bar = xcd_barrier_post((unsigned*)(ws + WS_CTL), misc, wv);
#define IN(k) (lo <= (k) && (k) < hi)
#define SEAM(k) do { if (IN(k) && IN((k) + 1)) xcd_barrier(bar); } while (0)
    const int G = gridDim.x;
    const int cid = (int)blockIdx.x;
    if (IN(0)) p0_prologue(a, lds, wv);
    SEAM(0);
#define MK_LAYER(l) do { \
        const int pb = 1 + 7 * l; \
        const float* modl = (const float*)(ws + WS_MOD) + (size_t)l * 8 * 6 * DM; \
        if (IN(pb)) { if (l == 0) norm_phase<0>(a, lds, 0, wv); else norm_phase<1>(a, lds, 1, wv); } \
        SEAM(pb); \
        if (IN(pb + 1)) { \
            pg8::DenseOrder S; S.init(NTOK, 6144, DM, (const bf16_t*)(ws + WS_WIN) + (size_t)l * 6144 * DM, G, cid); \
            pg8::EpiInProj E{ws, (float*)(ws + WS_KMEAN) + (size_t)l * 8 * 8 * 8 * 128, (const float*)(ws + WS_ROPE), (const float*)(ws + WS_LA)}; \
            pg8::gemm_phase(lds, (const bf16_t*)(ws + WS_H), DM, S, E, wv); \
        } \
        SEAM(pb + 1); \
        if (IN(pb + 2)) { \
            if (blockIdx.x < 32) gla::gla_unit(lds, ws, a.in[9] + l * 256, (int)blockIdx.x >> 2, (int)blockIdx.x & 3, wv); \
            { int dlo = 0, dhi = DEF_CAP3; \
              if (l == 1) { const int idle = moe_idle_wgs((const int*)(ws + WS_CNT), G); dlo = DEF_CAP3 + idle * (DEF_TPB6 + DEF_TPB7); dhi = NT_DEF - DEF_RES13; dlo = dlo < dhi ? dlo : dhi; } \
              attn::attn_cvt_phase(a, lds, (unsigned*)(ws + WS_CTL + 20480) + l * 64, (unsigned*)(ws + WS_CTL + 20480) + 128 + l * 64, l, dlo, dhi, l == 0 ? 12 : 20, wv); } \
        } \
        SEAM(pb + 2); \
        if (IN(pb + 3)) { \
            pg8::DenseOrder S; S.init(NTOK, DM, DM, (const bf16_t*)(ws + WS_WOUT) + (size_t)l * DM * DM, G, cid); \
            pg8::EpiResGate E{l == 0 ? a.in[0] : (const float*)(ws + WS_X), (float*)(ws + WS_X), modl + 2 * DM}; \
            pg8::gemm_phase(lds, (const bf16_t*)(ws + WS_MIX), DM, S, E, wv); \
        } \
        SEAM(pb + 3); \
        if (IN(pb + 4)) norm_phase<2>(a, lds, l, wv); \
        SEAM(pb + 4); \
        if (IN(pb + 5)) { \
            LAS int* tb = (LAS int*)(lds + 131072 + 1024); \
            pg8::moe_tiles((const int*)(ws + WS_CNT) + l * NEXP, tb, wv); \
            LAS int* rowtab = (LAS int*)(lds + 131072 + 2048); \
            pg8::MoeOrder S{(const int*)(ws + WS_SLOT), (const bf16_t*)(ws + WS_WGU) + (size_t)l * NEXP * 2048 * DM, DM, G, cid, 1, tb, rowtab}; \
            S.fill_rows(mk_tid(wv)); \
            pg8::EpiMoe1 E{rowtab, (bf16_t*)(ws + WS_ACT)}; \
            pg8::gemm_phase(lds, (const bf16_t*)(ws + WS_H), DM, S, E, wv); \
            if (l == 0) cvt_deferred(a, lds, wv, (unsigned*)(ws + WS_CTL + 20480) + 128 + 5 * 64, NT_DEF, NT_DEF + DEF_RES6); \
            else cvt_deferred(a, lds, wv, (unsigned*)(ws + WS_CTL + 20480) + 128 + 4 * 64, NT_DEF - DEF_RES13, NT_DEF); \
        } \
        SEAM(pb + 5); \
        if (IN(pb + 6)) { \
            LAS int* tb = (LAS int*)(lds + 131072 + 1024); \
            pg8::moe_tiles((const int*)(ws + WS_CNT) + l * NEXP, tb, wv); \
            LAS int* rowtab = (LAS int*)(lds + 131072 + 2048); \
            pg8::MoeOrder S{(const int*)(ws + WS_SLOT), (const bf16_t*)(ws + WS_WD) + (size_t)l * NEXP * DM * DEXP, DEXP, G, cid, 0, tb, rowtab}; \
            S.fill_rows(mk_tid(wv)); \
            pg8::EpiMoe2 E{rowtab, (bf16_t*)(ws + WS_YB)}; \
            pg8::gemm_phase(lds, (const bf16_t*)(ws + WS_ACT), DEXP, S, E, wv); \
            if (l == 0) cvt_deferred(a, lds, wv, (unsigned*)(ws + WS_CTL + 20480) + 128 + 6 * 64, NT_DEF + DEF_RES6, NT_DEF + DEF_RES6 + DEF_RES7); \
        } \
        SEAM(pb + 6); \
    } while (0)
    MK_LAYER(0);
    MK_LAYER(1);
#undef MK_LAYER
    if (IN(15)) norm_phase<3>(a, lds, 1, wv);
#undef IN
#undef SEAM
}

static void mk_launch(const MkArgs& base, int lo, int hi, hipStream_t stream) {
    static bool attr = false;
    if (!attr) { (void)hipFuncSetAttribute((const void*)mk_fwd, hipFuncAttributeMaxDynamicSharedMemorySize, LDS_BYTES); attr = true; }
    MkArgs a = base; a.ph_lo = lo; a.ph_hi = hi;
    hipLaunchKernelGGL(mk_fwd, dim3(256), dim3(512), LDS_BYTES, stream, a);
}

extern "C" void kernel_launch(void* const* d_in, const int* in_sizes, int n_in, void* d_out, int out_size, void* d_ws, size_t ws_size, hipStream_t stream) {
    MkArgs base{};
    for (int i = 0; i < 19; ++i) base.in[i] = (const float*)d_in[i];
    base.out = (float*)d_out; base.ws = (unsigned char*)d_ws;
    (void)hipMemsetAsync((unsigned char*)d_ws + WS_CTL, 0, CTL_BYTES, stream);
    mk_launch(base, 0, NPHASE, stream);
}
```
